# Optimizing an MI355X kernel written in HIP

```python
import math
import jax, jax.numpy as jnp
from jax import lax
import numpy as np

D_MODEL = 2048
BATCH = 2
SEQ = 4096
DEPTH = 1

MLA_HEADS = 8
MLA_NOPE = 128
MLA_ROPE = 64
MLA_V = 128
KV_RANK = 512
ROPE_THETA = 10000.0
MLA_WIDTH = MLA_HEADS * MLA_V

DIFF_HEADS = 8
DIFF_QK = 64
DIFF_V = 2 * DIFF_QK
DIFF_WIDTH = DIFF_HEADS * DIFF_V

Q_BLOCK = 128
EPS = 1e-6
NEG_INF = -1e30

SPLITS = (
    MLA_HEADS * (MLA_NOPE + MLA_ROPE),
    KV_RANK,
    MLA_ROPE,
    DIFF_HEADS * 2 * DIFF_QK,
    DIFF_HEADS * 2 * DIFF_QK,
    DIFF_WIDTH,
    MLA_WIDTH,
    DIFF_WIDTH,
    D_MODEL,
    D_MODEL,
)
IN_WIDTH = sum(SPLITS)

kernel_name = "hybrid_mla_diffattn_gated_block"


def rms_norm(x, g):
    xf = x.astype(jnp.float32)
    y = xf * lax.rsqrt(jnp.mean(xf * xf, axis=-1, keepdims=True) + EPS)
    return (y * g.astype(jnp.float32)).astype(x.dtype)


def rope(x, pos):
    half = x.shape[-1] // 2
    inv = ROPE_THETA ** (-jnp.arange(half, dtype=jnp.float32) / half)
    ang = pos.astype(jnp.float32)[..., None] * inv
    cos = jnp.cos(ang)[:, :, None, :]
    sin = jnp.sin(ang)[:, :, None, :]
    x1 = x[..., :half].astype(jnp.float32)
    x2 = x[..., half:].astype(jnp.float32)
    out = jnp.concatenate([x1 * cos - x2 * sin, x2 * cos + x1 * sin], axis=-1)
    return out.astype(x.dtype)


def mla_attention(q_nope, q_rope, k_nope, k_rope, v):
    B, S, H, dv = v.shape
    scale = (MLA_NOPE + MLA_ROPE) ** -0.5
    k_idx = jnp.arange(S)

    def block(i):
        start = i * Q_BLOCK
        qn = lax.dynamic_slice_in_dim(q_nope, start, Q_BLOCK, axis=1)
        qr = lax.dynamic_slice_in_dim(q_rope, start, Q_BLOCK, axis=1)
        s = (jnp.einsum('bqhd,bkhd->bhqk', qn, k_nope).astype(jnp.float32)
             + jnp.einsum('bqhd,bkd->bhqk', qr, k_rope).astype(jnp.float32)) * scale
        q_idx = start + jnp.arange(Q_BLOCK)
        causal = k_idx[None, :] <= q_idx[:, None]
        s = jnp.where(causal[None, None], s, NEG_INF)
        p = jax.nn.softmax(s, axis=-1)
        return jnp.einsum('bhqk,bkhd->bqhd', p.astype(v.dtype), v)

    out = lax.map(block, jnp.arange(S // Q_BLOCK))
    return out.transpose(1, 0, 2, 3, 4).reshape(B, S, H, dv)


def diff_attention(q, k, v, pos, lam):
    B, S, H, dv = v.shape
    scale = DIFF_QK ** -0.5
    slopes = 2.0 ** (-8.0 * jnp.arange(1, H + 1, dtype=jnp.float32) / H)
    posf = pos.astype(jnp.float32)
    k_idx = jnp.arange(S)

    def block(i):
        start = i * Q_BLOCK
        qb = lax.dynamic_slice_in_dim(q, start, Q_BLOCK, axis=1)
        pq = lax.dynamic_slice_in_dim(posf, start, Q_BLOCK, axis=1)
        s = jnp.einsum('bqhcd,bkhcd->bchqk', qb, k).astype(jnp.float32) * scale
        dist = jnp.abs(pq[:, :, None] - posf[:, None, :])
        s = s - slopes[None, None, :, None, None] * dist[:, None, None]
        q_idx = start + jnp.arange(Q_BLOCK)
        causal = k_idx[None, :] <= q_idx[:, None]
        s = jnp.where(causal[None, None, None], s, NEG_INF)
        p = jax.nn.softmax(s, axis=-1)
        a = p[:, 0] - lam * p[:, 1]
        return jnp.einsum('bhqk,bkhd->bqhd', a.astype(v.dtype), v)

    out = lax.map(block, jnp.arange(S // Q_BLOCK))
    return out.transpose(1, 0, 2, 3, 4).reshape(B, S, H, dv)


def setup_inputs(seed: int = 0) -> dict:
    key = jax.random.key(seed)
    ks = jax.random.split(key, 20)
    f32 = jnp.float32

    def w(k, shape, fan_in, mult=1.0):
        return jax.random.normal(k, shape, f32) * (mult * fan_in ** -0.5)

    def gain(k, shape):
        return 1.0 + 0.02 * jax.random.normal(k, shape, f32)

    x = jax.random.normal(ks[0], (BATCH, SEQ, D_MODEL), f32)
    c = jax.random.normal(ks[1], (BATCH, D_MODEL), f32)
    positions = jnp.broadcast_to(jnp.arange(SEQ, dtype=jnp.int32)[None, :], (BATCH, SEQ))
    return {
        "x": x,
        "c": c,
        "positions": positions,
        "w_ada": w(ks[2], (DEPTH, D_MODEL, 3 * D_MODEL), D_MODEL, 0.2),
        "b_ada": 0.01 * jax.random.normal(ks[3], (DEPTH, 3 * D_MODEL), f32),
        "g_pre": gain(ks[4], (DEPTH, D_MODEL)),
        "w_in": w(ks[5], (DEPTH, D_MODEL, IN_WIDTH), D_MODEL),
        "g_kv": gain(ks[6], (DEPTH, KV_RANK)),
        "w_ukv": w(ks[7], (DEPTH, KV_RANK, MLA_HEADS * (MLA_NOPE + MLA_V)), KV_RANK),
        "lambda_q1": 0.1 * jax.random.normal(ks[8], (DEPTH, DIFF_QK), f32),
        "lambda_k1": 0.1 * jax.random.normal(ks[9], (DEPTH, DIFF_QK), f32),
        "lambda_q2": 0.1 * jax.random.normal(ks[10], (DEPTH, DIFF_QK), f32),
        "lambda_k2": 0.1 * jax.random.normal(ks[11], (DEPTH, DIFF_QK), f32),
        "g_subln": gain(ks[12], (DEPTH, DIFF_V)),
        "w_o_mla": w(ks[13], (DEPTH, MLA_WIDTH, D_MODEL), MLA_WIDTH),
        "w_o_diff": w(ks[14], (DEPTH, DIFF_WIDTH, D_MODEL), DIFF_WIDTH),
        "w_out": w(ks[15], (DEPTH, D_MODEL, D_MODEL), D_MODEL),
        "g_post": gain(ks[16], (DEPTH, D_MODEL)),
    }


def reference(x, c, positions, w_ada, b_ada, g_pre, w_in, g_kv, w_ukv,
              lambda_q1, lambda_k1, lambda_q2, lambda_k2, g_subln,
              w_o_mla, w_o_diff, w_out, g_post):
    B, S, _ = x.shape
    split_points = []
    acc = 0
    for n in SPLITS[:-1]:
        acc += n
        split_points.append(acc)

    for l in range(DEPTH):
        lambda_init = 0.8 - 0.6 * math.exp(-0.3 * l)

        ada = c @ w_ada[l] + b_ada[l]
        shift, scale, gate = jnp.split(ada, 3, axis=-1)
        h = rms_norm(x, g_pre[l]) * (1.0 + scale[:, None]) + shift[:, None]

        proj = h @ w_in[l]
        (q_mla, c_kv, k_rope, q_diff, k_diff, v_diff,
         gate_mla, gate_diff, mg_mla, mg_diff) = jnp.split(proj, split_points, axis=-1)

        q_mla = q_mla.reshape(B, S, MLA_HEADS, MLA_NOPE + MLA_ROPE)
        q_nope = q_mla[..., :MLA_NOPE]
        q_rope = rope(q_mla[..., MLA_NOPE:], positions)
        kv = rms_norm(c_kv, g_kv[l]) @ w_ukv[l]
        kv = kv.reshape(B, S, MLA_HEADS, MLA_NOPE + MLA_V)
        k_nope = kv[..., :MLA_NOPE]
        v_mla = kv[..., MLA_NOPE:]
        k_rope = rope(k_rope[:, :, None, :], positions)[:, :, 0]
        o_mla = mla_attention(q_nope, q_rope, k_nope, k_rope, v_mla).reshape(B, S, MLA_WIDTH)
        y_mla = (o_mla * jax.nn.silu(gate_mla)) @ w_o_mla[l]

        lam = (jnp.exp(jnp.sum(lambda_q1[l].astype(jnp.float32) * lambda_k1[l].astype(jnp.float32)))
               - jnp.exp(jnp.sum(lambda_q2[l].astype(jnp.float32) * lambda_k2[l].astype(jnp.float32)))
               + lambda_init)
        qd = q_diff.reshape(B, S, DIFF_HEADS, 2, DIFF_QK)
        kd = k_diff.reshape(B, S, DIFF_HEADS, 2, DIFF_QK)
        vd = v_diff.reshape(B, S, DIFF_HEADS, DIFF_V)
        o_diff = diff_attention(qd, kd, vd, positions, lam)
        o_diff = (rms_norm(o_diff, g_subln[l]) * (1.0 - lambda_init)).reshape(B, S, DIFF_WIDTH)
        y_diff = (o_diff * jax.nn.silu(gate_diff)) @ w_o_diff[l]

        merged = jax.nn.sigmoid(mg_mla) * y_mla + jax.nn.sigmoid(mg_diff) * y_diff
        y = merged @ w_out[l]

        x = x + gate[:, None] * rms_norm(y, g_post[l])
    return x
```

```cpp
#include <hip/hip_runtime.h>
#include <hip/hip_cooperative_groups.h>
#include <cstdio>
#include <cstdint>
namespace pg8 {
#define PG8_LAS __attribute__((address_space(3)))
typedef unsigned short bf16_t;
typedef short bf16x8 __attribute__((ext_vector_type(8)));
typedef float f32x4 __attribute__((ext_vector_type(4)));
typedef unsigned u32x4 __attribute__((ext_vector_type(4)));
constexpr int BM = 256, BK = 64, HALF = 128, HTB = HALF * BK * 2  , STAGE_BYTES = 8 * HTB, NXCD = 8, WGM = 8;

__host__ __device__ __forceinline__ int lds_byte(int r, int c) { const int st = (r >> 4) * 2 + (c >> 5), rr = r & 15, cc = c & 31, ob = rr * 64 + cc * 2; return st * 1024 + (ob ^ (((ob >> 9) & 1) << 5)); }
__host__ __device__ __forceinline__ void stage_rc(int b, int& R, int& C) { const int st = b / 1024, sb = b % 1024, swz = sb ^ (((sb >> 9) & 1) << 5); R = (st >> 1) * 16 + swz / 64; C = (st & 1) * 32 + (swz % 64) / 2; }
__host__ __device__ __forceinline__ int perm32(int rho) { const int n = rho >> 4, i = rho & 15; return 8 * (i >> 2) + 4 * n + (i & 3); }

struct Unit { int pm, pn; };
struct Gemm { const bf16_t* A; const bf16_t* Bt; int M, N, K; };

struct StaticOrder {
    int nM, nN, nwg, G, c;
    __host__ __device__ void init(int M, int N, int G_, int c_) { nM = M / BM; nN = N / BM; nwg = nM * nN; G = G_; c = c_; }
    __host__ __device__ bool next(int i, Unit& u) const {
        const long L = (long)i * G + c; if (L >= nwg) return false;
        int wgid = (int)L; { const int q = nwg / NXCD, r = nwg % NXCD, xcd = wgid % NXCD, off = wgid / NXCD; wgid = (xcd < r ? xcd * (q + 1) : r * (q + 1) + (xcd - r) * q) + off; }
        const int nig = WGM * nN, gid = wgid / nig, fm = gid * WGM, gsz = (nM - fm) < WGM ? (nM - fm) : WGM;
        u.pm = fm + ((wgid % nig) % gsz); u.pn = (wgid % nig) / gsz; return true;
    }
    __device__ __forceinline__ void a_ready(const Unit&) const {}
    __device__ __forceinline__ void done(const Unit&) const {}
};

__device__ __forceinline__ unsigned cvt_pk_bf16(float lo, float hi) { unsigned r; asm volatile("v_cvt_pk_bf16_f32 %0, %1, %2" : "=v"(r) : "v"(lo), "v"(hi)); return r; }
template <class Epi, class Sched, bool ALIGN_EPI = false, bool SP2 = false>
__device__ __forceinline__ void gemm_phase(PG8_LAS unsigned char* lds, const Gemm g, const Sched& S, const Epi& E) {
    int tid_ = threadIdx.x; asm volatile("" : "+v"(tid_));
    const int tid = tid_, wid = __builtin_amdgcn_readfirstlane(tid >> 6), lane = tid & 63, wr = wid >> 2, wc = wid & 3, fr = lane & 15, fq = lane >> 4;
    const int K = g.K, nt = K / BK;
    unsigned voffA[2], voffB[2];
#pragma unroll
    for (int i = 0; i < 2; ++i) { int R, C; stage_rc(tid * 16 + i * 8192, R, C); const int Rb = Epi::PERM ? ((R & ~31) + perm32(R & 31)) : R;
        voffA[i] = (unsigned)(R * K + C) * 2u; voffB[i] = (unsigned)(Rb * K + C) * 2u; }
    const size_t kstep = (size_t)(BK * 2);
    const size_t hstep = (size_t)HALF * K * 2;
    const size_t tstep = 2 * hstep;
    const unsigned ldsw = (unsigned)wid * 1024u;
    const int aoff = lds_byte(wr * 64 + fr, fq * 8), boff = lds_byte(wc * 32 + fr, fq * 8);
#define PG8_SA(b, h) (((b) * 2 + (h)) * HTB)
#define PG8_SB(b, h) ((4 + (b) * 2 + (h)) * HTB)
#define PG8_STAGE(bufoff, gbase, voff) do { _Pragma("unroll") for (int _i = 0; _i < 2; ++_i) \
        __builtin_amdgcn_global_load_lds((const unsigned*)((const char*)(gbase) + (voff)[_i]), (PG8_LAS unsigned*)(lds + (bufoff) + ldsw + _i * 8192), 16, 0, 0); } while (0)
#define PG8_LDA(dst, b, h) do { _Pragma("unroll") for (int m = 0; m < 4; ++m) _Pragma("unroll") for (int k = 0; k < 2; ++k) dst[m][k] = *(const PG8_LAS bf16x8*)(lds + PG8_SA(b, h) + aoff + m * 2048 + k * 1024); } while (0)
#define PG8_LDB(dst, b, h) do { _Pragma("unroll") for (int n = 0; n < 2; ++n) _Pragma("unroll") for (int k = 0; k < 2; ++k) dst[n][k] = *(const PG8_LAS bf16x8*)(lds + PG8_SB(b, h) + boff + n * 2048 + k * 1024); } while (0)
#define PG8_MMA(ai, bj, At, Bt) do { __builtin_amdgcn_s_setprio(1); _Pragma("unroll") for (int m = 0; m < 4; ++m) _Pragma("unroll") for (int n = 0; n < 2; ++n) _Pragma("unroll") for (int k = 0; k < 2; ++k) \
        acc[ai][bj][m][n] = __builtin_amdgcn_mfma_f32_16x16x32_bf16(Bt[n][k], At[m][k], acc[ai][bj][m][n], 0, 0, 0); __builtin_amdgcn_s_setprio(0); } while (0)
#define PG8_WAIT_V(n) asm volatile("s_waitcnt vmcnt(" #n ")" ::: "memory")
#define PG8_WAIT_L(n) asm volatile("s_waitcnt lgkmcnt(" #n ")" ::: "memory")
#define PG8_BAR __builtin_amdgcn_s_barrier()
#define PG8_SCHED __builtin_amdgcn_sched_barrier(0)
    Unit cur, nxt; int ui = 0;
    if (!S.next(0, cur)) return;
    f32x4 acc[2][2][4][2];
#pragma unroll
    for (int a = 0; a < 2; ++a)
#pragma unroll
        for (int b = 0; b < 2; ++b)
#pragma unroll
            for (int m = 0; m < 4; ++m)
#pragma unroll
                for (int n = 0; n < 2; ++n) acc[a][b][m][n] = (f32x4){0.f, 0.f, 0.f, 0.f};
    bf16x8 At[4][2], B0[2][2], B1[2][2];
    const char* cA = (const char*)g.A + (size_t)cur.pm * tstep; const char* cB = (const char*)g.Bt + (size_t)cur.pn * tstep;
    S.a_ready(cur);
    if constexpr (SP2) {
        PG8_STAGE(PG8_SB(0, 0), cB, voffB); PG8_STAGE(PG8_SB(0, 1), cB + hstep, voffB); PG8_STAGE(PG8_SA(0, 0), cA, voffA); PG8_STAGE(PG8_SA(0, 1), cA + hstep, voffA);
        if (wr == 1) PG8_BAR;
        PG8_WAIT_V(2); PG8_BAR;
        PG8_STAGE(PG8_SB(1, 0), cB + kstep, voffB); PG8_STAGE(PG8_SA(1, 0), cA + kstep, voffA); PG8_STAGE(PG8_SB(1, 1), cB + hstep + kstep, voffB);
        PG8_WAIT_V(6); PG8_BAR;
    } else {
        PG8_STAGE(PG8_SB(0, 0), cB, voffB); PG8_STAGE(PG8_SA(0, 0), cA, voffA); PG8_STAGE(PG8_SB(0, 1), cB + hstep, voffB); PG8_STAGE(PG8_SA(0, 1), cA + hstep, voffA);
        if (wr == 1) PG8_BAR;
        PG8_WAIT_V(4); PG8_BAR;
        PG8_STAGE(PG8_SB(1, 0), cB + kstep, voffB); PG8_STAGE(PG8_SA(1, 0), cA + kstep, voffA); PG8_STAGE(PG8_SB(1, 1), cB + hstep + kstep, voffB);
        PG8_WAIT_V(6); PG8_BAR;
    }
    for (;;) {
        const bool has_next = S.next(ui + 1, nxt);
        const char* nA = has_next ? (const char*)g.A + (size_t)nxt.pm * tstep : cA; const char* nB = has_next ? (const char*)g.Bt + (size_t)nxt.pn * tstep : cB;
        for (int t = 0; t < nt; t += 2) {
            const bool last = (t == nt - 2);
            const char* a1 = cA + (size_t)(t + 1) * kstep;
            const char* a2 = last ? nA : cA + (size_t)(t + 2) * kstep; const char* b2 = last ? nB : cB + (size_t)(t + 2) * kstep;
            const char* a3 = a2 + kstep; const char* b3 = b2 + kstep;
            if (last && has_next) S.a_ready(nxt);
            if constexpr (SP2) {
            PG8_LDB(B0, 0, 0); PG8_LDB(B1, 0, 1); PG8_SCHED; PG8_LDA(At, 0, 0); PG8_STAGE(PG8_SA(1, 1), a1 + hstep, voffA);
            PG8_WAIT_V(8); PG8_WAIT_L(0); PG8_BAR; PG8_MMA(0, 0, At, B0); PG8_MMA(0, 1, At, B1); PG8_BAR; PG8_SCHED;
            PG8_LDA(At, 0, 1); PG8_STAGE(PG8_SB(0, 0), b2, voffB); PG8_STAGE(PG8_SB(0, 1), b2 + hstep, voffB); PG8_STAGE(PG8_SA(0, 0), a2, voffA);
            PG8_WAIT_V(8); PG8_WAIT_L(0); PG8_BAR; PG8_MMA(1, 0, At, B0); PG8_MMA(1, 1, At, B1); PG8_BAR; PG8_SCHED;
            PG8_LDB(B0, 1, 0); PG8_LDB(B1, 1, 1); PG8_SCHED; PG8_LDA(At, 1, 0); PG8_STAGE(PG8_SA(0, 1), a2 + hstep, voffA);
            PG8_WAIT_V(8); PG8_WAIT_L(0); PG8_BAR; PG8_MMA(0, 0, At, B0); PG8_MMA(0, 1, At, B1); PG8_BAR; PG8_SCHED;
            PG8_LDA(At, 1, 1); PG8_STAGE(PG8_SB(1, 0), b3, voffB); PG8_STAGE(PG8_SB(1, 1), b3 + hstep, voffB); PG8_STAGE(PG8_SA(1, 0), a3, voffA);
            PG8_WAIT_V(8); PG8_WAIT_L(0); PG8_BAR; PG8_MMA(1, 0, At, B0); PG8_MMA(1, 1, At, B1); PG8_BAR; PG8_SCHED;
            } else {
            PG8_LDB(B0, 0, 0); PG8_SCHED; PG8_LDA(At, 0, 0); PG8_STAGE(PG8_SA(1, 1), a1 + hstep, voffA);
            PG8_WAIT_L(8); PG8_BAR; PG8_WAIT_L(0); PG8_MMA(0, 0, At, B0); PG8_BAR; PG8_SCHED;
            PG8_LDB(B1, 0, 1); PG8_STAGE(PG8_SB(0, 0), b2, voffB);
            PG8_BAR; PG8_WAIT_L(0); PG8_MMA(0, 1, At, B1); PG8_BAR;
            PG8_LDA(At, 0, 1); PG8_STAGE(PG8_SA(0, 0), a2, voffA);
            PG8_BAR; PG8_WAIT_L(0); PG8_MMA(1, 0, At, B0); PG8_BAR; PG8_SCHED;
            PG8_STAGE(PG8_SB(0, 1), b2 + hstep, voffB);
            PG8_WAIT_V(6); PG8_BAR; PG8_MMA(1, 1, At, B1); PG8_BAR;
            PG8_LDB(B0, 1, 0); PG8_SCHED; PG8_LDA(At, 1, 0); PG8_STAGE(PG8_SA(0, 1), a2 + hstep, voffA);
            PG8_WAIT_L(8); PG8_BAR; PG8_WAIT_L(0); PG8_MMA(0, 0, At, B0); PG8_BAR; PG8_SCHED;
            PG8_LDB(B1, 1, 1); PG8_STAGE(PG8_SB(1, 0), b3, voffB);
            PG8_BAR; PG8_WAIT_L(0); PG8_MMA(0, 1, At, B1); PG8_BAR;
            PG8_LDA(At, 1, 1); PG8_STAGE(PG8_SA(1, 0), a3, voffA);
            PG8_BAR; PG8_WAIT_L(0); PG8_MMA(1, 0, At, B0); PG8_BAR; PG8_SCHED;
            PG8_STAGE(PG8_SB(1, 1), b3 + hstep, voffB);
            PG8_WAIT_V(6); PG8_BAR; PG8_MMA(1, 1, At, B1); PG8_BAR;
            }
        }
        if constexpr (ALIGN_EPI) { if (wr == 0) PG8_BAR; }
        if constexpr (!Epi::AFTER_DRAIN) { E(acc, cur, wr, wc, fr, fq); S.done(cur); }
        if (!has_next) break;
#pragma unroll
        for (int a = 0; a < 2; ++a)
#pragma unroll
            for (int b = 0; b < 2; ++b)
#pragma unroll
                for (int m = 0; m < 4; ++m)
#pragma unroll
                    for (int n = 0; n < 2; ++n) acc[a][b][m][n] = (f32x4){0.f, 0.f, 0.f, 0.f};
        cur = nxt; cA = nA; cB = nB; ++ui;
        if constexpr (ALIGN_EPI) { if (wr == 1) PG8_BAR; }
    }
    PG8_WAIT_V(0);
    if constexpr (!ALIGN_EPI) { if (wr == 0) PG8_BAR; }
    PG8_BAR;
    if constexpr (Epi::AFTER_DRAIN) { E.fused(acc, cur, wr, wc, fr, fq, lds, wid, lane); S.done(cur); }
#undef PG8_SA
#undef PG8_SB
#undef PG8_STAGE
#undef PG8_LDA
#undef PG8_LDB
#undef PG8_MMA
#undef PG8_WAIT_V
#undef PG8_WAIT_L
#undef PG8_BAR
#undef PG8_SCHED
}
}

namespace cg = cooperative_groups;
#ifndef PROBE_DUP
#define PROBE_DUP -1
#endif
#ifndef PROBE_DRY
#define PROBE_DRY 0
#endif
#ifndef STATIC_PLAN
#define STATIC_PLAN 0
#endif
#define LAS __attribute__((address_space(3)))
typedef unsigned short bf16_t;
typedef short bf16x8 __attribute__((ext_vector_type(8)));
typedef short s16x4 __attribute__((ext_vector_type(4)));
typedef float f32x4 __attribute__((ext_vector_type(4)));
typedef float f32x16 __attribute__((ext_vector_type(16)));
typedef unsigned u32x4 __attribute__((ext_vector_type(4)));
typedef unsigned u32x2 __attribute__((ext_vector_type(2)));

constexpr int DM = 2048, NB = 2, SEQ = 4096, MTOK = NB * SEQ;
constexpr int INW = 11328, INWP = 11520;
constexpr float EPS = 1e-6f;
constexpr float LOG2E = 1.4426950408889634f;
constexpr float QS_MLA = 0.07216878364870322f * LOG2E;
constexpr float QS_DIF = 0.125f * LOG2E;
constexpr float LAMBDA_INIT = 0.2f;

constexpr size_t MiB = 1u << 20;
constexpr size_t WS_CTL = 0;
constexpr size_t CTL_BYTES = 1 * MiB;
constexpr size_t WS_ROPE = 2 * MiB;
constexpr size_t WS_WUKV = 4 * MiB, WS_WOM = 6 * MiB, WS_WOD = 10 * MiB, WS_WOUT = 14 * MiB, WS_WIN = 22 * MiB;
constexpr size_t WS_H = 67 * MiB;
constexpr size_t WS_QM = 99 * MiB, WS_CKV = 123 * MiB, WS_KM = 131 * MiB, WS_VM = 155 * MiB;
constexpr size_t WS_QD = 171 * MiB, WS_KD = 187 * MiB, WS_VD = 203 * MiB, WS_GM = 219 * MiB, WS_GD = 235 * MiB;
constexpr size_t WS_SM = 251 * MiB, WS_SD = 283 * MiB, WS_OA = 315 * MiB, WS_END = 347 * MiB;
constexpr size_t WS_Y = 99 * MiB;
constexpr int CTL_BAR = 32768;
constexpr int CTL_SSQC = 0, CTL_SSQY = 8192, CTL_ADA = 16384, CTL_QUEUE = 16384 + 12288;

constexpr int LDS_MAIN = 131072, LDS_MISC = 131072, LDS_BYTES = 135168;

__device__ __forceinline__ unsigned f2bf(float f) { unsigned u = __builtin_bit_cast(unsigned, f); return (u + 0x7fffu + ((u >> 16) & 1u)) >> 16; }
typedef float f32x2_t __attribute__((ext_vector_type(2))); typedef __bf16 bf16x2_t __attribute__((ext_vector_type(2)));
__device__ __forceinline__ unsigned pk2(float lo, float hi) { f32x2_t v = {lo, hi}; bf16x2_t b = __builtin_convertvector(v, bf16x2_t); return __builtin_bit_cast(unsigned, b); }
__device__ __forceinline__ float fexp2(float v) { return __builtin_amdgcn_exp2f(v); }
__device__ __forceinline__ float bf2f(unsigned short b) { return __builtin_bit_cast(float, (unsigned)b << 16); }
__device__ __forceinline__ float bflo(unsigned w) { return __builtin_bit_cast(float, w << 16); }
__device__ __forceinline__ float bfhi(unsigned w) { return __builtin_bit_cast(float, w & 0xffff0000u); }
__device__ __forceinline__ float wave_sum(float v) {
#pragma unroll
    for (int o = 1; o < 64; o <<= 1) v += __shfl_xor(v, o);
    return v;
}
__device__ __forceinline__ float fsigmoid(float v) { return __builtin_amdgcn_rcpf(1.0f + fexp2(-1.4426950408889634f * v)); }

__device__ __forceinline__ int vsrc_in(int v) {
    if (v < 1536) { const int hd = v / 192, w = v - hd * 192; if (w < 128) return v; const int r = w - 128; return hd * 192 + 128 + (r >> 1) + 32 * (r & 1); }
    if (v < 2048) return v;
    if (v < 11264) return v + 64;
    if (v < 11328) { const int r = v - 11264; return 2048 + (r >> 1) + 32 * (r & 1); }
    return -1;
}

namespace epi {
using pg8::Unit;
__device__ __forceinline__ void st8(bf16_t* p, f32x4 a, f32x4 b) {
    u32x4 w; w.x = pk2(a[0], a[1]); w.y = pk2(a[2], a[3]); w.z = pk2(b[0], b[1]); w.w = pk2(b[2], b[3]); *(u32x4*)p = w;
}
__device__ __forceinline__ void rope8(f32x4& v0, f32x4& v1, const float* rc, const float* rs) {
    const f32x4 c4 = *(const f32x4*)rc, s4 = *(const f32x4*)rs;
    f32x4 a, b;
    a[0] = v0[0] * c4[0] - v0[1] * s4[0]; a[1] = v0[1] * c4[0] + v0[0] * s4[0];
    a[2] = v0[2] * c4[1] - v0[3] * s4[1]; a[3] = v0[3] * c4[1] + v0[2] * s4[1];
    b[0] = v1[0] * c4[2] - v1[1] * s4[2]; b[1] = v1[1] * c4[2] + v1[0] * s4[2];
    b[2] = v1[2] * c4[3] - v1[3] * s4[3]; b[3] = v1[3] * c4[3] + v1[2] * s4[3];
    v0 = a; v1 = b;
}
template <int ACT> __device__ __forceinline__ void store_tile(const f32x4 (&acc)[2][2][4][2], bf16_t* dst, int ldc, int colt, int rowb, int colw, float sc) {
#pragma unroll
    for (int ai = 0; ai < 2; ++ai)
#pragma unroll
        for (int m = 0; m < 4; ++m) { bf16_t* rowp = dst + (size_t)(rowb + ai * 128 + m * 16) * ldc + colt + colw;
#pragma unroll
            for (int bj = 0; bj < 2; ++bj) { f32x4 v0 = acc[ai][bj][m][0], v1 = acc[ai][bj][m][1];
                if (ACT == 1) { v0 = v0 * sc; v1 = v1 * sc; }
                if (ACT == 2) {
#pragma unroll
                    for (int i = 0; i < 4; ++i) { v0[i] = v0[i] * fsigmoid(v0[i]); v1[i] = v1[i] * fsigmoid(v1[i]); } }
                if (ACT == 3) {
#pragma unroll
                    for (int i = 0; i < 4; ++i) { v0[i] = fsigmoid(v0[i]); v1[i] = fsigmoid(v1[i]); } }
                st8(rowp + bj * 128, v0, v1); } }
}

struct EpiProj {
    static constexpr bool PERM = true, AFTER_DRAIN = false;
    bf16_t *QM, *CKV, *QD, *KD, *VD, *GM, *GD, *SM, *SD, *KM; float* ssq; const float* rc; const float* rs;
    __device__ __forceinline__ void operator()(const f32x4 (&acc)[2][2][4][2], const Unit& u, int wr, int wc, int fr, int fq) const {
        const int pn = u.pn, rowb = u.pm * 256 + wr * 64 + fr, colw = wc * 32 + 8 * fq;
        if (pn < 6) {
#pragma unroll
            for (int bj = 0; bj < 2; ++bj) { const int col = pn * 256 + bj * 128 + colw, w = col % 192; const bool rp = w >= 128; const int i0 = (w - 128) >> 1;
#pragma unroll
                for (int ai = 0; ai < 2; ++ai)
#pragma unroll
                    for (int m = 0; m < 4; ++m) { const int row = rowb + ai * 128 + m * 16; f32x4 v0 = acc[ai][bj][m][0], v1 = acc[ai][bj][m][1];
                        if (rp) rope8(v0, v1, rc + (size_t)row * 32 + i0, rs + (size_t)row * 32 + i0);
                        v0 = v0 * QS_MLA; v1 = v1 * QS_MLA; st8(QM + (size_t)row * 1536 + col, v0, v1); } }
        } else if (pn < 8) {
            const int colt = (pn - 6) * 256;
#pragma unroll
            for (int ai = 0; ai < 2; ++ai)
#pragma unroll
                for (int m = 0; m < 4; ++m) { const int row = rowb + ai * 128 + m * 16; float s = 0.f;
#pragma unroll
                    for (int bj = 0; bj < 2; ++bj) { const f32x4 v0 = acc[ai][bj][m][0], v1 = acc[ai][bj][m][1];
                        s += (v0[0] * v0[0] + v0[1] * v0[1]) + (v0[2] * v0[2] + v0[3] * v0[3]) + (v1[0] * v1[0] + v1[1] * v1[1]) + (v1[2] * v1[2] + v1[3] * v1[3]);
                        st8(CKV + (size_t)row * 512 + colt + bj * 128 + colw, v0, v1); }
                    s += __shfl_xor(s, 16); s += __shfl_xor(s, 32);
                    if (fq == 0) atomicAdd(ssq + row, s); }
        } else if (pn < 12) store_tile<1>(acc, QD, 1024, (pn - 8) * 256, rowb, colw, QS_DIF);
        else if (pn < 16) store_tile<0>(acc, KD, 1024, (pn - 12) * 256, rowb, colw, 1.f);
        else if (pn < 20) store_tile<0>(acc, VD, 1024, (pn - 16) * 256, rowb, colw, 1.f);
        else if (pn < 24) store_tile<2>(acc, GM, 1024, (pn - 20) * 256, rowb, colw, 1.f);
        else if (pn < 28) store_tile<2>(acc, GD, 1024, (pn - 24) * 256, rowb, colw, 1.f);
        else if (pn < 36) store_tile<3>(acc, SM, 2048, (pn - 28) * 256, rowb, colw, 1.f);
        else if (pn < 44) store_tile<3>(acc, SD, 2048, (pn - 36) * 256, rowb, colw, 1.f);
        else {
            if (wc < 2) { const int i0 = colw >> 1;
#pragma unroll
                for (int ai = 0; ai < 2; ++ai)
#pragma unroll
                    for (int m = 0; m < 4; ++m) { const int row = rowb + ai * 128 + m * 16; f32x4 v0 = acc[ai][0][m][0], v1 = acc[ai][0][m][1];
                        rope8(v0, v1, rc + (size_t)row * 32 + i0, rs + (size_t)row * 32 + i0);
                        const int b = row >> 12, s = row & 4095;
#pragma unroll
                        for (int h = 0; h < 8; ++h) st8(KM + ((size_t)(b * 8 + h) * SEQ + s) * 192 + 128 + colw, v0, v1); } }
        }
    }
};
struct EpiUp {
    static constexpr bool PERM = true, AFTER_DRAIN = false;
    bf16_t *KM, *VM; const float* ssq;
    __device__ __forceinline__ void operator()(const f32x4 (&acc)[2][2][4][2], const Unit& u, int wr, int wc, int fr, int fq) const {
        const int h = u.pn, rowb = u.pm * 256 + wr * 64 + fr, colw = wc * 32 + 8 * fq;
#pragma unroll
        for (int ai = 0; ai < 2; ++ai)
#pragma unroll
            for (int m = 0; m < 4; ++m) { const int row = rowb + ai * 128 + m * 16; const float r = rsqrtf(ssq[row] * (1.0f / 512.0f) + EPS);
                const int b = row >> 12, s = row & 4095;
                st8(KM + ((size_t)(b * 8 + h) * SEQ + s) * 192 + colw, acc[ai][0][m][0] * r, acc[ai][0][m][1] * r);
                st8(VM + (size_t)row * 1024 + h * 128 + colw, acc[ai][1][m][0] * r, acc[ai][1][m][1] * r); }
    }
};
struct EpiO1 {
    static constexpr bool PERM = true, AFTER_DRAIN = false;
    bf16_t* Y; const bf16_t* S;
    __device__ __forceinline__ void operator()(const f32x4 (&acc)[2][2][4][2], const Unit& u, int wr, int wc, int fr, int fq) const {
        const int rowb = u.pm * 256 + wr * 64 + fr, colb = u.pn * 256 + wc * 32 + 8 * fq;
#pragma unroll
        for (int ai = 0; ai < 2; ++ai)
#pragma unroll
            for (int m = 0; m < 4; ++m)
#pragma unroll
                for (int bj = 0; bj < 2; ++bj) { const size_t off = (size_t)(rowb + ai * 128 + m * 16) * DM + colb + bj * 128;
                    const u32x4 g = *(const u32x4*)(S + off); f32x4 v0 = acc[ai][bj][m][0], v1 = acc[ai][bj][m][1];
                    v0[0] *= bflo(g.x); v0[1] *= bfhi(g.x); v0[2] *= bflo(g.y); v0[3] *= bfhi(g.y); v1[0] *= bflo(g.z); v1[1] *= bfhi(g.z); v1[2] *= bflo(g.w); v1[3] *= bfhi(g.w);
                    st8(Y + off, v0, v1); }
    }
};
struct EpiO2 {
    static constexpr bool PERM = true, AFTER_DRAIN = false;
    const bf16_t* Y; const bf16_t* S; bf16_t* MG;
    __device__ __forceinline__ void operator()(const f32x4 (&acc)[2][2][4][2], const Unit& u, int wr, int wc, int fr, int fq) const {
        const int rowb = u.pm * 256 + wr * 64 + fr, colb = u.pn * 256 + wc * 32 + 8 * fq;
#pragma unroll
        for (int ai = 0; ai < 2; ++ai)
#pragma unroll
            for (int m = 0; m < 4; ++m)
#pragma unroll
                for (int bj = 0; bj < 2; ++bj) { const size_t off = (size_t)(rowb + ai * 128 + m * 16) * DM + colb + bj * 128;
                    const u32x4 g = *(const u32x4*)(S + off); f32x4 v0 = acc[ai][bj][m][0], v1 = acc[ai][bj][m][1];
                    const u32x4 yy = *(const u32x4*)(Y + off); const f32x4 y0 = {bflo(yy.x), bfhi(yy.x), bflo(yy.y), bfhi(yy.y)}, y1 = {bflo(yy.z), bfhi(yy.z), bflo(yy.w), bfhi(yy.w)};
                    v0[0] = y0[0] + v0[0] * bflo(g.x); v0[1] = y0[1] + v0[1] * bfhi(g.x); v0[2] = y0[2] + v0[2] * bflo(g.y); v0[3] = y0[3] + v0[3] * bfhi(g.y);
                    v1[0] = y1[0] + v1[0] * bflo(g.z); v1[1] = y1[1] + v1[1] * bfhi(g.z); v1[2] = y1[2] + v1[2] * bflo(g.w); v1[3] = y1[3] + v1[3] * bfhi(g.w);
                    st8(MG + off, v0, v1); }
    }
};
struct EpiOut {
    static constexpr bool PERM = true, AFTER_DRAIN = false;
    bf16_t* Y; float* ssq;
    __device__ __forceinline__ void operator()(const f32x4 (&acc)[2][2][4][2], const Unit& u, int wr, int wc, int fr, int fq) const {
        const int rowb = u.pm * 256 + wr * 64 + fr, colb = u.pn * 256 + wc * 32 + 8 * fq;
#pragma unroll
        for (int ai = 0; ai < 2; ++ai)
#pragma unroll
            for (int m = 0; m < 4; ++m) { const int row = rowb + ai * 128 + m * 16; float s = 0.f;
#pragma unroll
                for (int bj = 0; bj < 2; ++bj) { const size_t off = (size_t)row * DM + colb + bj * 128; const f32x4 v0 = acc[ai][bj][m][0], v1 = acc[ai][bj][m][1];
                    s += (v0[0] * v0[0] + v0[1] * v0[1]) + (v0[2] * v0[2] + v0[3] * v0[3]) + (v1[0] * v1[0] + v1[1] * v1[1]) + (v1[2] * v1[2] + v1[3] * v1[3]);
                    st8(Y + off, v0, v1); }
                s += __shfl_xor(s, 16); s += __shfl_xor(s, 32);
                if (fq == 0) atomicAdd(ssq + row, s); }
    }
};
}

namespace att {
constexpr int KBUF = 25600, VBUF = 20480, VROW = 320;
constexpr int OFF_K = 0, OFF_V = 2 * KBUF, OFF_POS = OFF_V + 2 * VBUF, OFF_WSF = OFF_POS + 512, OFF_END = OFF_WSF + 8 * 256;
static_assert(OFF_END <= LDS_MAIN, "attention LDS");
constexpr float NEG = -1e30f;
struct Ptrs { const bf16_t *QM, *KM, *VM, *QD, *KD, *VD, *GM, *GD; bf16_t *OM, *OD; const int* pos; const float* gsub; float lam; };
__device__ __forceinline__ int crow(int r, int hi) { return (r & 3) + 8 * (r >> 2) + 4 * hi; }
__device__ __forceinline__ float xmax(float v) { const unsigned u = __float_as_uint(v); auto rr = __builtin_amdgcn_permlane32_swap(u, u, false, false); return fmaxf(__uint_as_float(rr[0]), __uint_as_float(rr[1])); }
__device__ __forceinline__ float xsum(float v) { const unsigned u = __float_as_uint(v); auto rr = __builtin_amdgcn_permlane32_swap(u, u, false, false); return __uint_as_float(rr[0]) + __uint_as_float(rr[1]); }
__device__ __forceinline__ s16x4 vtr(const LAS unsigned char* p) { return __builtin_bit_cast(s16x4, __builtin_amdgcn_ds_read_tr16_b64_v4i16((LAS s16x4*)p)); }
__device__ __forceinline__ bf16x8 pack8(const f32x16& p, int s) {
    u32x4 w; w.x = pk2(p[8 * s + 0], p[8 * s + 1]); w.y = pk2(p[8 * s + 2], p[8 * s + 3]); w.z = pk2(p[8 * s + 4], p[8 * s + 5]); w.w = pk2(p[8 * s + 6], p[8 * s + 7]);
    return __builtin_bit_cast(bf16x8, w);
}

template <bool MLA> __device__ __forceinline__ void attn_unit(LAS unsigned char* lds, const int b, const int h, const int qb, const Ptrs& P, const int dry) {
    constexpr int ROWS = MLA ? 256 : 128, DK = MLA ? 192 : 64, DKT = MLA ? 192 : 128, KROW = DKT * 2 + 16, CPR = DKT / 8, KCH = (64 * CPR) / 512, ND = DK / 16;
    int tid_ = threadIdx.x; asm volatile("" : "+v"(tid_));
    const int tid = tid_, lane = tid & 63, wid = __builtin_amdgcn_readfirstlane(tid >> 6), r32 = lane & 31, hi = lane >> 5;
    const int rg = MLA ? wid : (wid >> 1), c = MLA ? 0 : (wid & 1);
    const int q0 = qb * ROWS, q0w = q0 + 32 * rg, qabs = q0w + r32;
    const size_t tokb = (size_t)b * SEQ;
    const bf16_t* Kg = MLA ? P.KM + ((size_t)(b * 8 + h) * SEQ) * 192 : P.KD + tokb * 1024 + h * 128;
    constexpr int KLD = MLA ? 192 : 1024;
    const bf16_t* Vg = (MLA ? P.VM : P.VD) + tokb * 1024 + h * 128;
    bf16x8 qf[ND];
    { const bf16_t* Qg = MLA ? P.QM + (tokb + qabs) * 1536 + h * 192 : P.QD + (tokb + qabs) * 1024 + h * 128 + c * 64;
#pragma unroll
      for (int d0 = 0; d0 < ND; ++d0) qf[d0] = *(const bf16x8*)(Qg + d0 * 16 + hi * 8); }
    float posq = 0.f, slope2 = 0.f;
    if (!MLA) { posq = (float)P.pos[tokb + qabs]; slope2 = exp2f(-(float)(h + 1)) * LOG2E; }
#pragma unroll
    for (int d0 = 0; d0 < ND; ++d0) asm volatile("" : "+v"(qf[d0]));
    asm volatile("" : "+v"(posq), "+v"(slope2));
    u32x4 kreg[KCH], vreg[2]; float preg = 0.f;
    int krow[KCH], kch[KCH], vrow[2], vch[2];
#pragma unroll
    for (int i = 0; i < KCH; ++i) { const int idx = tid + 512 * i; krow[i] = idx / CPR; kch[i] = idx % CPR; }
#pragma unroll
    for (int i = 0; i < 2; ++i) { const int idx = tid + 512 * i; vrow[i] = idx >> 4; vch[i] = idx & 15; }
#define ATT_LOAD(j) do { const int kv0_ = 64 * (j); \
        _Pragma("unroll") for (int i = 0; i < KCH; ++i) kreg[i] = *(const u32x4*)(Kg + (size_t)(kv0_ + krow[i]) * KLD + kch[i] * 8); \
        _Pragma("unroll") for (int i = 0; i < 2; ++i) vreg[i] = *(const u32x4*)(Vg + (size_t)(kv0_ + vrow[i]) * 1024 + vch[i] * 8); \
        if (!MLA) { if (tid < 64) preg = (float)P.pos[tokb + kv0_ + tid]; } } while (0)
#define ATT_WRITE(bf) do { \
        _Pragma("unroll") for (int i = 0; i < KCH; ++i) *(LAS u32x4*)(lds + OFF_K + (bf) * KBUF + krow[i] * KROW + kch[i] * 16) = kreg[i]; \
        _Pragma("unroll") for (int i = 0; i < 2; ++i) *(LAS u32x4*)(lds + OFF_V + (bf) * VBUF + vrow[i] * VROW + vch[i] * 16) = vreg[i]; \
        if (!MLA) { if (tid < 64) *(LAS float*)(lds + OFF_POS + (bf) * 256 + tid * 4) = preg; } } while (0)

    LAS float* wsf = (LAS float*)(lds + OFF_WSF + wid * 256);
    f32x16 o[4];
#pragma unroll
    for (int d = 0; d < 4; ++d)
#pragma unroll
        for (int r = 0; r < 16; ++r) o[d][r] = 0.f;
    float mrun = NEG, lrun = 0.f;
    const int NT = (q0 + ROWS) / 64;
    const int kbase = (r32)*KROW + c * 128 + hi * 16;
    const int vbase = (4 * hi + ((lane & 15) >> 2)) * VROW + (((lane >> 4) & 1) * 16 + (lane & 3) * 4) * 2;

    ATT_LOAD(0);
    __syncthreads();
    ATT_WRITE(0);
    for (int j = 0; j < NT; ++j) {
        const int bf = j & 1;
        if (j + 1 < NT && !(dry & 4)) ATT_LOAD(j + 1);
        __syncthreads();
        const int kv0 = 64 * j;
#pragma unroll 1
        for (int kvh = 0; kvh < 2; ++kvh) {
            const int kvs = kv0 + 32 * kvh;
            if (kvs > q0w + 31 || (dry & 1) || ((dry & 8) && (wid & 4))) break;
            const LAS unsigned char* Kb = lds + OFF_K + bf * KBUF + kbase + kvh * 32 * KROW;
            bf16x8 kf[ND];
#pragma unroll
            for (int d0 = 0; d0 < ND; ++d0) kf[d0] = *(const LAS bf16x8*)(Kb + d0 * 32);
            __builtin_amdgcn_sched_barrier(0);
            f32x16 p;
#pragma unroll
            for (int r = 0; r < 16; ++r) p[r] = 0.f;
#pragma unroll
            for (int d0 = 0; d0 < ND; ++d0) p = __builtin_amdgcn_mfma_f32_32x32x16_bf16(kf[d0], qf[d0], p, 0, 0, 0);
            __builtin_amdgcn_sched_barrier(0);
            const LAS unsigned char* Vb = lds + OFF_V + bf * VBUF + vbase + kvh * 32 * VROW;
            s16x4 vlo[8], vhi[8];
#pragma unroll
            for (int s2 = 0; s2 < 2; ++s2)
#pragma unroll
                for (int db = 0; db < 4; ++db) { vlo[s2 * 4 + db] = vtr(Vb + s2 * 16 * VROW + db * 64); vhi[s2 * 4 + db] = vtr(Vb + s2 * 16 * VROW + 8 * VROW + db * 64); }
            __builtin_amdgcn_sched_barrier(0);
            if (!MLA) {
                const LAS float* pp = (const LAS float*)(lds + OFF_POS + bf * 256) + 32 * kvh + 4 * hi;
#pragma unroll
                for (int g = 0; g < 4; ++g) { const f32x4 a = *(const LAS f32x4*)(pp + 8 * g);
#pragma unroll
                    for (int i = 0; i < 4; ++i) p[4 * g + i] -= slope2 * fabsf(posq - a[i]); }
            }
            if (kvs + 31 > q0w) {
#pragma unroll
                for (int r = 0; r < 16; ++r) { if (kvs + crow(r, hi) > qabs) p[r] = NEG; }
            }
            float mx;
            { const float m0 = fmaxf(fmaxf(p[0], p[1]), fmaxf(p[2], p[3])), m1 = fmaxf(fmaxf(p[4], p[5]), fmaxf(p[6], p[7]));
              const float m2 = fmaxf(fmaxf(p[8], p[9]), fmaxf(p[10], p[11])), m3 = fmaxf(fmaxf(p[12], p[13]), fmaxf(p[14], p[15]));
              mx = fmaxf(fmaxf(m0, m1), fmaxf(m2, m3)); }
            mx = xmax(mx);
            const float mnew = fmaxf(mrun, mx), alpha = fexp2(mrun - mnew);
            mrun = mnew;
            float rs0 = 0.f, rs1 = 0.f, rs2 = 0.f, rs3 = 0.f;
#pragma unroll
            for (int r = 0; r < 16; r += 4) { p[r] = fexp2(p[r] - mnew); p[r + 1] = fexp2(p[r + 1] - mnew); p[r + 2] = fexp2(p[r + 2] - mnew); p[r + 3] = fexp2(p[r + 3] - mnew);
                rs0 += p[r]; rs1 += p[r + 1]; rs2 += p[r + 2]; rs3 += p[r + 3]; }
            lrun = lrun * alpha + ((rs0 + rs1) + (rs2 + rs3));
            if (__any(alpha != 1.0f)) {
                if (hi == 0) wsf[r32] = alpha;
#pragma unroll
                for (int g = 0; g < 4; ++g) { const f32x4 a4 = *(const LAS f32x4*)(wsf + 8 * g + 4 * hi);
#pragma unroll
                    for (int d = 0; d < 4; ++d)
#pragma unroll
                        for (int i = 0; i < 4; ++i) o[d][4 * g + i] *= a4[i]; }
            }
            __builtin_amdgcn_sched_barrier(0);
#pragma unroll
            for (int s2 = 0; s2 < 2; ++s2) {
                const bf16x8 pa = pack8(p, s2);
#pragma unroll
                for (int db = 0; db < 4; ++db) {
                    const s16x4 lo = vlo[s2 * 4 + db], hh = vhi[s2 * 4 + db];
                    const bf16x8 vb = (bf16x8){lo[0], lo[1], lo[2], lo[3], hh[0], hh[1], hh[2], hh[3]};
                    o[db] = __builtin_amdgcn_mfma_f32_32x32x16_bf16(pa, vb, o[db], 0, 0, 0);
                }
            }
        }
        if (j + 1 < NT && !(dry & 4)) ATT_WRITE(bf ^ 1);
    }
#undef ATT_LOAD
#undef ATT_WRITE
    int q0e = q0w, r32e = r32, hie = hi; asm volatile("" : "+s"(q0e), "+v"(r32e), "+v"(hie));
    if (dry) { if (dry & 1) asm volatile("" :: "v"(qf[0]), "v"(qf[ND - 1])); else asm volatile("" :: "v"(o[0]), "v"(o[1]), "v"(o[2]), "v"(o[3]), "v"(lrun)); return; }
    float lt = xsum(lrun);
    if (hie == 0) wsf[32 + r32e] = 1.0f / lt;
    f32x4 li[4];
#pragma unroll
    for (int g = 0; g < 4; ++g) li[g] = *(const LAS f32x4*)(wsf + 32 + 8 * g + 4 * hie);
    constexpr int SROW = 272;
    if (MLA) {
        __syncthreads();
        LAS unsigned char* stg = lds + wid * (32 * SROW);
#pragma unroll
        for (int r = 0; r < 16; ++r)
#pragma unroll
            for (int db = 0; db < 4; ++db) *(LAS bf16_t*)(stg + crow(r, hie) * SROW + (32 * db + r32e) * 2) = (bf16_t)f2bf(o[db][r] * li[r >> 2][r & 3]);
        asm volatile("s_waitcnt lgkmcnt(0)" ::: "memory");
#pragma unroll
        for (int i = 0; i < 8; ++i) { const int idx = i * 64 + lane, row = idx >> 4, ch = idx & 15;
            const u32x4 ov = *(const LAS u32x4*)(stg + row * SROW + ch * 16);
            const size_t off = (tokb + q0e + row) * 1024 + h * 128 + ch * 8;
            const u32x4 g = *(const u32x4*)(P.GM + off);
            u32x4 w; w.x = pk2(bflo(ov.x) * bflo(g.x), bfhi(ov.x) * bfhi(g.x)); w.y = pk2(bflo(ov.y) * bflo(g.y), bfhi(ov.y) * bfhi(g.y));
            w.z = pk2(bflo(ov.z) * bflo(g.z), bfhi(ov.z) * bfhi(g.z)); w.w = pk2(bflo(ov.w) * bflo(g.w), bfhi(ov.w) * bfhi(g.w));
            *(u32x4*)(P.OM + off) = w; }
    } else {
        LAS float* comb = (LAS float*)lds;
        __syncthreads();
        if (c == 1) {
#pragma unroll
            for (int r = 0; r < 16; ++r)
#pragma unroll
                for (int db = 0; db < 4; ++db) comb[((rg * 16 + r) * 2 + hie) * 128 + db * 32 + r32e] = o[db][r] * li[r >> 2][r & 3];
        }
        __syncthreads();
        if (c == 0) {
            float gs[4];
#pragma unroll
            for (int db = 0; db < 4; ++db) gs[db] = P.gsub[32 * db + r32e] * (1.0f - LAMBDA_INIT);
#pragma unroll
            for (int r = 0; r < 16; ++r)
#pragma unroll
                for (int db = 0; db < 4; ++db) o[db][r] = o[db][r] * li[r >> 2][r & 3] - P.lam * comb[((rg * 16 + r) * 2 + hie) * 128 + db * 32 + r32e];
            asm volatile("s_waitcnt lgkmcnt(0)" ::: "memory");
            LAS unsigned char* stg = lds + rg * 16384;
#pragma unroll
            for (int r = 0; r < 16; ++r) { float ss = 0.f;
#pragma unroll
                for (int db = 0; db < 4; ++db) ss += o[db][r] * o[db][r];
                ss += __shfl_xor(ss, 1); ss += __shfl_xor(ss, 2); ss += __shfl_xor(ss, 4); ss += __shfl_xor(ss, 8); ss += __shfl_xor(ss, 16);
                const float rstd = rsqrtf(ss * (1.0f / 128.0f) + EPS);
#pragma unroll
                for (int db = 0; db < 4; ++db) *(LAS bf16_t*)(stg + crow(r, hie) * SROW + (32 * db + r32e) * 2) = (bf16_t)f2bf(o[db][r] * rstd * gs[db]); }
            asm volatile("s_waitcnt lgkmcnt(0)" ::: "memory");
#pragma unroll
            for (int i = 0; i < 8; ++i) { const int idx = i * 64 + lane, row = idx >> 4, ch = idx & 15;
                const u32x4 ov = *(const LAS u32x4*)(stg + row * SROW + ch * 16);
                const size_t off = (tokb + q0e + row) * 1024 + h * 128 + ch * 8;
                const u32x4 g = *(const u32x4*)(P.GD + off);
                u32x4 w; w.x = pk2(bflo(ov.x) * bflo(g.x), bfhi(ov.x) * bfhi(g.x)); w.y = pk2(bflo(ov.y) * bflo(g.y), bfhi(ov.y) * bfhi(g.y));
                w.z = pk2(bflo(ov.z) * bflo(g.z), bfhi(ov.z) * bfhi(g.z)); w.w = pk2(bflo(ov.w) * bflo(g.w), bfhi(ov.w) * bfhi(g.w));
                *(u32x4*)(P.OD + off) = w; }
        }
    }
}
}

#define XB_TMO      128
#define XB_XCNT(j)  (256  + 64 * (j))
#define XB_XSUB(j)  (1280 + 64 * (j))
#define XB_XGEN(j)  (2304 + 64 * (j))
#define XB_TOP      3328
#define XB_TOPGEN   3392
#define XCD_BAR_WORDS 3456
#define XB_SPIN_CAP (1u << 18)

__device__ __forceinline__ unsigned xb_ld(unsigned* p)              { return __hip_atomic_load(p, __ATOMIC_RELAXED, __HIP_MEMORY_SCOPE_AGENT); }
__device__ __forceinline__ unsigned xb_add(unsigned* p, unsigned v) { return __hip_atomic_fetch_add(p, v, __ATOMIC_RELAXED, __HIP_MEMORY_SCOPE_AGENT); }
__device__ __forceinline__ unsigned xb_xcc_id() { return (unsigned)__builtin_amdgcn_s_getreg((3 << 11) | 20) & 0xFu; }
#define XB_SPIN(cond, bar) do { unsigned _sp = 0; while (cond) { __builtin_amdgcn_s_sleep(1); \
    if ((++_sp & 255u) == 0u) { if (xb_ld(&(bar)[XB_TMO])) break; if (_sp > XB_SPIN_CAP) { atomicAdd(&(bar)[XB_TMO], 1u); break; } } } } while (0)

struct XcdBarrier {
    unsigned* bar; unsigned x;
    volatile LAS unsigned* st;
};

__device__ __forceinline__ XcdBarrier xcd_barrier_post(unsigned* bar, volatile LAS unsigned* st) {
    XcdBarrier b; b.bar = bar; b.x = xb_xcc_id(); b.st = st;
    if (threadIdx.x == 0) (void)xb_add(&bar[XB_XCNT(b.x)], 1u);
    return b;
}
__device__ __forceinline__ void xcd_barrier_complete(unsigned* bar, unsigned x, unsigned& nloc, unsigned& nx) {
    const unsigned G = gridDim.x * gridDim.y * gridDim.z;
    unsigned sum, cnt, mine, sp = 0u;
    for (;;) {
        sum = 0u; cnt = 0u; mine = 0u;
#pragma unroll
        for (unsigned j = 0; j < 16; ++j) { const unsigned c = xb_ld(&bar[XB_XCNT(j)]); sum += c; cnt += (c > 0u) ? 1u : 0u; mine = (j == x) ? c : mine; }
        if (sum == G) break;
        __builtin_amdgcn_s_sleep(1);
        if ((++sp & 255u) == 0u) { if (xb_ld(&bar[XB_TMO])) break; if (sp > XB_SPIN_CAP) { atomicAdd(&bar[XB_TMO], 1u); break; } }
    }
    nloc = mine > 0u ? mine : 1u; nx = cnt > 0u ? cnt : 1u;
}

__device__ __forceinline__ void xcd_barrier(const XcdBarrier& b) {
    asm volatile("s_waitcnt vmcnt(0)" ::: "memory");
    __syncthreads();
    if (threadIdx.x == 0) {
        unsigned* bar = b.bar;
        __builtin_amdgcn_s_waitcnt(0);
        unsigned nloc = b.st[0], nx = b.st[1];
        if (nloc == 0u) { xcd_barrier_complete(bar, b.x, nloc, nx); b.st[0] = nloc; b.st[1] = nx; }
        const unsigned old = xb_add(&bar[XB_XSUB(b.x)], 1u);
        const unsigned gen = old / nloc;
        if (old + 1u == (gen + 1u) * nloc) {
            __builtin_amdgcn_fence(__ATOMIC_RELEASE, "agent");
            asm volatile("s_waitcnt vmcnt(0)" ::: "memory");
            const unsigned og = xb_add(&bar[XB_TOP], 1u);
            const unsigned tg = og / nx;
            if (og + 1u == (tg + 1u) * nx) xb_add(&bar[XB_TOPGEN], 1u);
            else XB_SPIN(xb_ld(&bar[XB_TOPGEN]) == tg, bar);
            __builtin_amdgcn_fence(__ATOMIC_ACQUIRE, "agent");
            xb_add(&bar[XB_XGEN(b.x)], 1u);
            asm volatile("s_waitcnt vmcnt(0)" ::: "memory");
        } else {
            XB_SPIN(xb_ld(&bar[XB_XGEN(b.x)]) == gen, bar);
            __builtin_amdgcn_fence(__ATOMIC_ACQUIRE, "agent");
            asm volatile("s_waitcnt vmcnt(0)" ::: "memory");
        }
    }
    __syncthreads();
}

struct TrDesc { const float* W; bf16_t* WT; const float* gk; int K, N, k0, n0, mode; };
__device__ __forceinline__ void tr_load(const TrDesc& d, float (&vv)[32], int lane) {
    int sc = d.n0 + (lane & 31); if (d.mode == 1) sc = vsrc_in(sc);
    const float* src = d.W + (size_t)(d.k0 + (lane >> 5)) * d.N + (sc < 0 ? 0 : sc);
    const size_t step = (size_t)2 * d.N;
#pragma unroll
    for (int i = 0; i < 32; ++i) { const float v = src[i * step]; vv[i] = (sc < 0) ? 0.f : v; }
}
__device__ __forceinline__ void tr_store(const TrDesc& d, const float (&vv)[32], LAS float* scr, int lane) {
#pragma unroll
    for (int i = 0; i < 32; ++i) { const int kk = 2 * i + (lane >> 5); float v = vv[i];
        if (d.mode == 2) v *= d.gk[d.k0 + kk];
        scr[kk * 33 + (lane & 31)] = v; }
    asm volatile("s_waitcnt lgkmcnt(0)" ::: "memory");
    const int c = lane & 7;
#pragma unroll
    for (int j = 0; j < 4; ++j) { const int n = (lane >> 3) + 8 * j; const LAS float* sp = scr + (8 * c) * 33 + n;
        u32x4 o; o.x = pk2(sp[0 * 33], sp[1 * 33]); o.y = pk2(sp[2 * 33], sp[3 * 33]); o.z = pk2(sp[4 * 33], sp[5 * 33]); o.w = pk2(sp[6 * 33], sp[7 * 33]);
        *(u32x4*)(d.WT + (size_t)(d.n0 + n) * d.K + d.k0 + 8 * c) = o; }
    asm volatile("s_waitcnt lgkmcnt(0)" ::: "memory");
}

struct Args {
    const float *x, *c; const int* pos; const float *w_ada, *b_ada, *g_pre, *w_in, *g_kv, *w_ukv, *lq1, *lk1, *lq2, *lk2, *g_subln, *w_o_mla, *w_o_diff, *w_out, *g_post;
    float* out; unsigned char* ws;
};

__global__ void __launch_bounds__(512, 2) fwd_kernel(Args A) {
    extern __shared__ __attribute__((aligned(16))) unsigned char lds_raw[];
    LAS unsigned char* lds = (LAS unsigned char*)lds_raw;
    cg::grid_group grid = cg::this_grid();
    if (A.ws == nullptr) grid.sync();
    { volatile LAS unsigned* st0 = (volatile LAS unsigned*)(lds + LDS_MISC + 64); if (threadIdx.x < 2) st0[threadIdx.x] = 0u; }
    __syncthreads();
    const XcdBarrier xbar = xcd_barrier_post((unsigned*)(A.ws + WS_CTL) + CTL_BAR, (volatile LAS unsigned*)(lds + LDS_MISC + 64));
#if PROBE_DUP == 9
#define GRID_SYNC() do { xcd_barrier(xbar); xcd_barrier(xbar); } while (0)
#else
#define GRID_SYNC() xcd_barrier(xbar)
#endif
    const int G = gridDim.x, NGW = G * 8;
#define PHASE_IDS() int tid = threadIdx.x; asm volatile("" : "+v"(tid)); const int lane = tid & 63, wave = __builtin_amdgcn_readfirstlane(tid >> 6), gw = blockIdx.x * 8 + wave; (void)lane; (void)gw
    unsigned char* ws = A.ws;
    float* ctl = (float*)(ws + WS_CTL);
    float* ssqc = ctl + CTL_SSQC; float* ssqy = ctl + CTL_SSQY; float* ada = ctl + CTL_ADA; unsigned* queue = (unsigned*)(ctl + CTL_QUEUE);
    float* ropec = (float*)(ws + WS_ROPE); float* ropes = ropec + MTOK * 32;
    bf16_t *WUKV = (bf16_t*)(ws + WS_WUKV), *WOM = (bf16_t*)(ws + WS_WOM), *WOD = (bf16_t*)(ws + WS_WOD), *WOUT = (bf16_t*)(ws + WS_WOUT), *WIN = (bf16_t*)(ws + WS_WIN);
    bf16_t *H = (bf16_t*)(ws + WS_H), *MG = (bf16_t*)(ws + WS_H);
    bf16_t *QM = (bf16_t*)(ws + WS_QM), *CKV = (bf16_t*)(ws + WS_CKV), *KM = (bf16_t*)(ws + WS_KM), *VM = (bf16_t*)(ws + WS_VM);
    bf16_t *QD = (bf16_t*)(ws + WS_QD), *KD = (bf16_t*)(ws + WS_KD), *VD = (bf16_t*)(ws + WS_VD), *GM = (bf16_t*)(ws + WS_GM), *GD = (bf16_t*)(ws + WS_GD);
    bf16_t *SM = (bf16_t*)(ws + WS_SM), *SD = (bf16_t*)(ws + WS_SD), *OM = (bf16_t*)(ws + WS_OA), *OD = (bf16_t*)(ws + WS_OA + 16 * MiB);
    bf16_t* Y = (bf16_t*)(ws + WS_Y);

    {
        PHASE_IDS();
#if PROBE_DUP == 0
#define P0SKIP(rep) ((rep) ? PROBE_DRY : 0)
        for (int rep = 0; rep < 2; ++rep) { float* ada_ = rep ? ctl + 65536 : ada;
#else
#define P0SKIP(rep) 0
        { float* ada_ = ada; const int rep = 0; (void)rep;
#endif
        LAS float* scr = (LAS float*)(lds + wave * 8448);
        constexpr int I_IN = 32 * (INWP / 32), I_UKV = 8 * 64, I_OM = 16 * 64, I_OD = 16 * 64, I_OUT = 32 * 64, I_ADA = 96 * 32;
        constexpr int NTR = I_IN + I_UKV + I_OM + I_OD + I_OUT;
        if (!(P0SKIP(rep) & 1))
        for (int r = gw; r < I_ADA; r += NGW) {
            const int cb = r % 96, kc = r / 96, j = cb * 64 + lane, k0 = kc * 64; float a0 = 0.f, a1 = 0.f;
#pragma unroll
            for (int k = 0; k < 64; ++k) { const float w = A.w_ada[(size_t)(k0 + k) * 6144 + j]; a0 += A.c[k0 + k] * w; a1 += A.c[DM + k0 + k] * w; }
            atomicAdd(ada_ + j, a0); atomicAdd(ada_ + 6144 + j, a1);
        }
#define TR_DECODE(d, it_) do { int r_ = (it_); \
            if (r_ < I_IN) { d.W = A.w_in; d.WT = WIN; d.gk = nullptr; d.K = DM; d.N = INW; d.mode = 1; d.k0 = 64 * (r_ % 32); d.n0 = 32 * (r_ / 32); } \
            else if ((r_ -= I_IN) < I_UKV) { d.W = A.w_ukv; d.WT = WUKV; d.gk = A.g_kv; d.K = 512; d.N = 2048; d.mode = 2; d.k0 = 64 * (r_ % 8); d.n0 = 32 * (r_ / 8); } \
            else if ((r_ -= I_UKV) < I_OM) { d.W = A.w_o_mla; d.WT = WOM; d.gk = nullptr; d.K = 1024; d.N = 2048; d.mode = 0; d.k0 = 64 * (r_ % 16); d.n0 = 32 * (r_ / 16); } \
            else if ((r_ -= I_OM) < I_OD) { d.W = A.w_o_diff; d.WT = WOD; d.gk = nullptr; d.K = 1024; d.N = 2048; d.mode = 0; d.k0 = 64 * (r_ % 16); d.n0 = 32 * (r_ / 16); } \
            else { r_ -= I_OD; d.W = A.w_out; d.WT = WOUT; d.gk = nullptr; d.K = 2048; d.N = 2048; d.mode = 0; d.k0 = 64 * (r_ % 32); d.n0 = 32 * (r_ / 32); } } while (0)
        if (!(P0SKIP(rep) & 2)) {
            float va[32], vb[32]; TrDesc da, db; int it = gw;
            if (it < NTR) { TR_DECODE(da, it); tr_load(da, va, lane); }
            while (it < NTR) {
                const int i1 = it + NGW, i2 = it + 2 * NGW;
                if (i1 < NTR) { TR_DECODE(db, i1); tr_load(db, vb, lane); }
                tr_store(da, va, scr, lane);
                if (i1 >= NTR) break;
                if (i2 < NTR) { TR_DECODE(da, i2); tr_load(da, va, lane); }
                tr_store(db, vb, scr, lane);
                it = i2;
            }
        }
#undef TR_DECODE
        if (!(P0SKIP(rep) & 4)) {
            LAS float* invt = (LAS float*)(lds + 8 * 8448);
            __syncthreads();
            if (tid < 32) invt[tid] = powf(10000.0f, -(float)tid / 32.0f);
            __syncthreads();
            for (int e = blockIdx.x * 512 + tid; e < MTOK * 32; e += G * 512) {
                const int t = e >> 5, i = e & 31;
                const float ang = (float)A.pos[t] * invt[i];
                const float k = rintf(ang * 0.6366197723675814f);
                float r = fmaf(-k, 1.5703125f, ang); r = fmaf(-k, 4.837512969970703125e-4f, r); r = fmaf(-k, 7.54978995489188216e-8f, r);
                const float r2 = r * r;
                const float sn = r + r * r2 * (-1.6666667163e-1f + r2 * (8.3333337680e-3f + r2 * (-1.9841270114e-4f + r2 * 2.7557314297e-6f)));
                const float cs = 1.0f + r2 * (-0.5f + r2 * (4.1666667908e-2f + r2 * (-1.3888889225e-3f + r2 * (2.4801587642e-5f + r2 * -2.7557314297e-7f))));
                const int qd = ((int)k) & 3;
                const float s_ = (qd == 0) ? sn : (qd == 1) ? cs : (qd == 2) ? -sn : -cs;
                const float c_ = (qd == 0) ? cs : (qd == 1) ? -sn : (qd == 2) ? -cs : sn;
                ropec[e] = c_; ropes[e] = s_;
            }
        }
        }
    }
    GRID_SYNC();

    {
        PHASE_IDS();
        LAS float* mA = (LAS float*)lds;
        LAS float* mB = mA + 2 * DM;
        for (int e = tid; e < 2 * DM; e += 512) { const int b = e >> 11, n = e & 2047;
            mA[e] = A.g_pre[n] * (1.0f + ada[b * 6144 + 2048 + n] + A.b_ada[2048 + n]); mB[e] = ada[b * 6144 + n] + A.b_ada[n]; }
        __syncthreads();
        for (int m = gw; m < MTOK; m += NGW) {
            const int b = m >> 12; const f32x4* xr = (const f32x4*)(A.x + (size_t)m * DM) + lane;
            f32x4 v[8]; float s = 0.f;
#pragma unroll
            for (int j = 0; j < 8; ++j) { v[j] = xr[64 * j]; s += (v[j][0] * v[j][0] + v[j][1] * v[j][1]) + (v[j][2] * v[j][2] + v[j][3] * v[j][3]); }
            const float rstd = rsqrtf(wave_sum(s) * (1.0f / DM) + EPS);
            u32x2* o8 = (u32x2*)(H + (size_t)m * DM) + lane;
#pragma unroll
            for (int j = 0; j < 8; ++j) { const int n = b * DM + 256 * j + 4 * lane; const f32x4 a = *(const LAS f32x4*)(mA + n), sh = *(const LAS f32x4*)(mB + n);
                u32x2 w; w.x = pk2(v[j][0] * rstd * a[0] + sh[0], v[j][1] * rstd * a[1] + sh[1]); w.y = pk2(v[j][2] * rstd * a[2] + sh[2], v[j][3] * rstd * a[3] + sh[3]);
                o8[64 * j] = w; }
        }
        __syncthreads();
    }
    GRID_SYNC();

#ifndef SKIP_P2
    {
        pg8::Gemm g{H, WIN, MTOK, INWP, DM}; pg8::StaticOrder S; S.init(MTOK, INWP, G, (int)blockIdx.x);
        epi::EpiProj E{QM, CKV, QD, KD, VD, GM, GD, SM, SD, KM, ssqc, ropec, ropes};
        pg8::gemm_phase<epi::EpiProj, pg8::StaticOrder, true, true>(lds, g, S, E);
#if PROBE_DUP == 2
        __syncthreads();
        epi::EpiProj E2{QM, CKV, QD, KD, VD, GM, GD, SM, SD, KM, ctl + 65536, ropec, ropes};
        pg8::gemm_phase<epi::EpiProj, pg8::StaticOrder, true, true>(lds, g, S, E2);
#endif
    }
#endif
    GRID_SYNC();

    {
        pg8::Gemm g{CKV, WUKV, MTOK, 2048, 512}; pg8::StaticOrder S; S.init(MTOK, 2048, G, (int)blockIdx.x);
        epi::EpiUp E{KM, VM, ssqc};
        pg8::gemm_phase<epi::EpiUp, pg8::StaticOrder, true, true>(lds, g, S, E);
    }
    GRID_SYNC();

#ifndef SKIP_P4
    {
        PHASE_IDS();
        att::Ptrs P; P.QM = QM; P.KM = KM; P.VM = VM; P.QD = QD; P.KD = KD; P.VD = VD; P.GM = GM; P.GD = GD; P.OM = OM; P.OD = OD; P.pos = A.pos; P.gsub = A.g_subln;
        { const float s1 = wave_sum(A.lq1[lane] * A.lk1[lane]), s2 = wave_sum(A.lq2[lane] * A.lk2[lane]); P.lam = expf(s1) - expf(s2) + LAMBDA_INIT; }
        LAS unsigned* qslot = (LAS unsigned*)(lds + LDS_MISC);
#if PROBE_DUP == 4
        for (int rep = 0; rep < 2; ++rep)
#else
        const int rep = 0;
#endif
        if (STATIC_PLAN && G == 256) {
            const int x = blockIdx.x & 7, k = blockIdx.x >> 3;
            if (k < 16) { const int bh = 2 * x + (k >> 3), i = k & 7;
                att::attn_unit<true>(lds, bh >> 3, bh & 7, 15 - i, P, rep ? PROBE_DRY : 0);
                att::attn_unit<true>(lds, bh >> 3, bh & 7, i, P, rep ? PROBE_DRY : 0);
            } else { const int j = k - 16;
#pragma unroll 1
                for (int u = 0; u < 4; ++u) { const int bh = 2 * x + (u & 1), qb = (u < 2) ? 31 - j : j;
                    att::attn_unit<false>(lds, bh >> 3, bh & 7, qb, P, rep ? PROBE_DRY : 0); }
            }
        } else
        for (;;) {
            __syncthreads();
            if (tid == 0) *qslot = atomicAdd(queue + rep, 1u);
            __syncthreads();
            int rem = (int)*qslot;
            if (rem >= 768) break;
            int type = -1, qb = 0;
            for (int cv = 160; cv >= 3; --cv) {
                if (cv % 10 == 0) { if (rem < 16) { type = 0; qb = cv / 10 - 1; break; } rem -= 16; }
                if (cv % 3 == 0 && cv <= 96) { if (rem < 16) { type = 1; qb = cv / 3 - 1; break; } rem -= 16; }
            }
            const int b = rem >> 3, h = rem & 7;
            if (type == 0) att::attn_unit<true>(lds, b, h, qb, P, rep ? PROBE_DRY : 0);
            else att::attn_unit<false>(lds, b, h, qb, P, rep ? PROBE_DRY : 0);
        }
        __syncthreads();
    }
#endif
    GRID_SYNC();

    {
        pg8::StaticOrder S; S.init(MTOK, DM, G, (int)blockIdx.x);
        { pg8::Gemm g{OM, WOM, MTOK, DM, 1024}; epi::EpiO1 E{Y, SM}; pg8::gemm_phase<epi::EpiO1, pg8::StaticOrder, true, true>(lds, g, S, E); }
        __syncthreads();
        { pg8::Gemm g{OD, WOD, MTOK, DM, 1024}; epi::EpiO2 E{Y, SD, MG}; pg8::gemm_phase<epi::EpiO2, pg8::StaticOrder, true, true>(lds, g, S, E); }
    }
    GRID_SYNC();

    {
        pg8::Gemm g{MG, WOUT, MTOK, DM, DM}; pg8::StaticOrder S; S.init(MTOK, DM, G, (int)blockIdx.x);
        epi::EpiOut E{Y, ssqy};
        pg8::gemm_phase<epi::EpiOut, pg8::StaticOrder, true, true>(lds, g, S, E);
    }
    GRID_SYNC();

    {
        PHASE_IDS();
        LAS float* gg = (LAS float*)lds;
        for (int e = tid; e < 2 * DM; e += 512) { const int b = e >> 11, n = e & 2047; gg[e] = (ada[b * 6144 + 4096 + n] + A.b_ada[4096 + n]) * A.g_post[n]; }
        __syncthreads();
        for (int m = gw; m < MTOK; m += NGW) {
            const int b = m >> 12; const float rstd = rsqrtf(ssqy[m] * (1.0f / DM) + EPS);
            const f32x4* xr = (const f32x4*)(A.x + (size_t)m * DM) + lane; const u32x2* yr = (const u32x2*)(Y + (size_t)m * DM) + lane; f32x4* orow = (f32x4*)(A.out + (size_t)m * DM) + lane;
#pragma unroll
            for (int j = 0; j < 8; ++j) { const f32x4 g4 = *(const LAS f32x4*)(gg + b * DM + 256 * j + 4 * lane); const u32x2 yy = yr[64 * j]; const f32x4 y4 = {bflo(yy.x), bfhi(yy.x), bflo(yy.y), bfhi(yy.y)};
                orow[64 * j] = xr[64 * j] + y4 * g4 * rstd; }
        }
    }
}

extern "C" void kernel_launch(void* const* d_in, const int* in_sizes, int n_in, void* d_out, int out_size, void* d_ws, size_t ws_size, hipStream_t stream) {
    static int grid_blocks = 0;
    if (grid_blocks == 0) {
        if (n_in != 18 || in_sizes[0] != MTOK * DM || out_size != MTOK * DM || ws_size < WS_END) { fprintf(stderr, "kernel_launch: unexpected shapes (n_in %d, in0 %d, out %d, ws %zu)\n", n_in, n_in > 0 ? in_sizes[0] : -1, out_size, ws_size); grid_blocks = -1; return; }
        int dev = 0, cus = 0, per_cu = 0;
        (void)hipGetDevice(&dev); (void)hipDeviceGetAttribute(&cus, hipDeviceAttributeMultiprocessorCount, dev);
        if (hipFuncSetAttribute((const void*)fwd_kernel, hipFuncAttributeMaxDynamicSharedMemorySize, LDS_BYTES) != hipSuccess) { fprintf(stderr, "kernel_launch: hipFuncSetAttribute failed\n"); grid_blocks = -1; return; }
        if (hipOccupancyMaxActiveBlocksPerMultiprocessor(&per_cu, (const void*)fwd_kernel, 512, LDS_BYTES) != hipSuccess || per_cu < 1) { fprintf(stderr, "kernel_launch: occupancy query says %d\n", per_cu); per_cu = 1; }
        (void)hipGetLastError();
        grid_blocks = cus;
    }
    if (grid_blocks < 0) return;
    (void)hipMemsetAsync((char*)d_ws + WS_CTL, 0, CTL_BYTES, stream);
    Args a{};
    a.x = (const float*)d_in[0]; a.c = (const float*)d_in[1]; a.pos = (const int*)d_in[2]; a.w_ada = (const float*)d_in[3]; a.b_ada = (const float*)d_in[4]; a.g_pre = (const float*)d_in[5];
    a.w_in = (const float*)d_in[6]; a.g_kv = (const float*)d_in[7]; a.w_ukv = (const float*)d_in[8]; a.lq1 = (const float*)d_in[9]; a.lk1 = (const float*)d_in[10]; a.lq2 = (const float*)d_in[11]; a.lk2 = (const float*)d_in[12];
    a.g_subln = (const float*)d_in[13]; a.w_o_mla = (const float*)d_in[14]; a.w_o_diff = (const float*)d_in[15]; a.w_out = (const float*)d_in[16]; a.g_post = (const float*)d_in[17];
    a.out = (float*)d_out; a.ws = (unsigned char*)d_ws;
    void* args[] = {&a};
    hipError_t e = hipLaunchCooperativeKernel((const void*)fwd_kernel, dim3(grid_blocks), dim3(512), args, LDS_BYTES, stream);
    if (e != hipSuccess) fprintf(stderr, "cooperative launch failed: %s (grid %d)\n", hipGetErrorString(e), grid_blocks);
}
```

```cpp
#include <hip/hip_runtime.h>
#include <hip/hip_cooperative_groups.h>
#include <cstdio>
#include <cstdint>
namespace pg8 {
#define PG8_LAS __attribute__((address_space(3)))
typedef unsigned short bf16_t;
typedef short bf16x8 __attribute__((ext_vector_type(8)));
typedef float f32x4 __attribute__((ext_vector_type(4)));
typedef unsigned u32x4 __attribute__((ext_vector_type(4)));
constexpr int BM = 256, BK = 64, HALF = 128, HTB = HALF * BK * 2  , STAGE_BYTES = 8 * HTB, NXCD = 8, WGM = 8;

__host__ __device__ __forceinline__ int lds_byte(int r, int c) { const int st = (r >> 4) * 2 + (c >> 5), rr = r & 15, cc = c & 31, ob = rr * 64 + cc * 2; return st * 1024 + (ob ^ (((ob >> 9) & 1) << 5)); }
__host__ __device__ __forceinline__ void stage_rc(int b, int& R, int& C) { const int st = b / 1024, sb = b % 1024, swz = sb ^ (((sb >> 9) & 1) << 5); R = (st >> 1) * 16 + swz / 64; C = (st & 1) * 32 + (swz % 64) / 2; }
__host__ __device__ __forceinline__ int perm32(int rho) { const int n = rho >> 4, i = rho & 15; return 8 * (i >> 2) + 4 * n + (i & 3); }

struct Unit { int pm, pn; };
struct Gemm { const bf16_t* A; const bf16_t* Bt; int M, N, K; };

struct StaticOrder {
    int nM, nN, nwg, G, c;
    __host__ __device__ void init(int M, int N, int G_, int c_) { nM = M / BM; nN = N / BM; nwg = nM * nN; G = G_; c = c_; }
    __host__ __device__ bool next(int i, Unit& u) const {
        const long L = (long)i * G + c; if (L >= nwg) return false;
        int wgid = (int)L; { const int q = nwg / NXCD, r = nwg % NXCD, xcd = wgid % NXCD, off = wgid / NXCD; wgid = (xcd < r ? xcd * (q + 1) : r * (q + 1) + (xcd - r) * q) + off; }
        const int nig = WGM * nN, gid = wgid / nig, fm = gid * WGM, gsz = (nM - fm) < WGM ? (nM - fm) : WGM;
        u.pm = fm + ((wgid % nig) % gsz); u.pn = (wgid % nig) / gsz; return true;
    }
    __device__ __forceinline__ void a_ready(const Unit&) const {}
    __device__ __forceinline__ void done(const Unit&) const {}
};

__device__ __forceinline__ unsigned cvt_pk_bf16(float lo, float hi) { unsigned r; asm volatile("v_cvt_pk_bf16_f32 %0, %1, %2" : "=v"(r) : "v"(lo), "v"(hi)); return r; }
struct NoHook { static constexpr bool ON = false; static constexpr int T = 0; template <class A_> __device__ __forceinline__ void mid(A_&, const Unit&, int, int, int, int) const {} };
template <class Epi, class Sched, bool ALIGN_EPI = false, bool SP2 = false, class Hook = NoHook>
__device__ __forceinline__ void gemm_phase(PG8_LAS unsigned char* lds, const Gemm g, const Sched& S, const Epi& E, const Hook& H = Hook()) {
    int tid_ = threadIdx.x; asm volatile("" : "+v"(tid_));
    const int tid = tid_, wid = __builtin_amdgcn_readfirstlane(tid >> 6), lane = tid & 63, wr = wid >> 2, wc = wid & 3, fr = lane & 15, fq = lane >> 4;
    const int K = g.K, nt = K / BK;
    unsigned voffA[2], voffB[2];
#pragma unroll
    for (int i = 0; i < 2; ++i) { int R, C; stage_rc(tid * 16 + i * 8192, R, C); const int Rb = Epi::PERM ? ((R & ~31) + perm32(R & 31)) : R;
        voffA[i] = (unsigned)(R * K + C) * 2u; voffB[i] = (unsigned)(Rb * K + C) * 2u; }
    const size_t kstep = (size_t)(BK * 2);
    const size_t hstep = (size_t)HALF * K * 2;
    const size_t tstep = 2 * hstep;
    const unsigned ldsw = (unsigned)wid * 1024u;
    const int aoff = lds_byte(wr * 64 + fr, fq * 8), boff = lds_byte(wc * 32 + fr, fq * 8);
#define PG8_SA(b, h) (((b) * 2 + (h)) * HTB)
#define PG8_SB(b, h) ((4 + (b) * 2 + (h)) * HTB)
#define PG8_STAGE(bufoff, gbase, voff) do { _Pragma("unroll") for (int _i = 0; _i < 2; ++_i) \
        __builtin_amdgcn_global_load_lds((const unsigned*)((const char*)(gbase) + (voff)[_i]), (PG8_LAS unsigned*)(lds + (bufoff) + ldsw + _i * 8192), 16, 0, 0); } while (0)
#define PG8_LDA(dst, b, h) do { _Pragma("unroll") for (int m = 0; m < 4; ++m) _Pragma("unroll") for (int k = 0; k < 2; ++k) dst[m][k] = *(const PG8_LAS bf16x8*)(lds + PG8_SA(b, h) + aoff + m * 2048 + k * 1024); } while (0)
#define PG8_LDB(dst, b, h) do { _Pragma("unroll") for (int n = 0; n < 2; ++n) _Pragma("unroll") for (int k = 0; k < 2; ++k) dst[n][k] = *(const PG8_LAS bf16x8*)(lds + PG8_SB(b, h) + boff + n * 2048 + k * 1024); } while (0)
#define PG8_MMA(ai, bj, At, Bt) do { __builtin_amdgcn_s_setprio(1); _Pragma("unroll") for (int m = 0; m < 4; ++m) _Pragma("unroll") for (int n = 0; n < 2; ++n) _Pragma("unroll") for (int k = 0; k < 2; ++k) \
        acc[ai][bj][m][n] = __builtin_amdgcn_mfma_f32_16x16x32_bf16(Bt[n][k], At[m][k], acc[ai][bj][m][n], 0, 0, 0); __builtin_amdgcn_s_setprio(0); } while (0)
#define PG8_WAIT_V(n) asm volatile("s_waitcnt vmcnt(" #n ")" ::: "memory")
#define PG8_WAIT_L(n) asm volatile("s_waitcnt lgkmcnt(" #n ")" ::: "memory")
#define PG8_BAR __builtin_amdgcn_s_barrier()
#define PG8_SCHED __builtin_amdgcn_sched_barrier(0)
    Unit cur, nxt; int ui = 0;
    if (!S.next(0, cur)) return;
    f32x4 acc[2][2][4][2];
#pragma unroll
    for (int a = 0; a < 2; ++a)
#pragma unroll
        for (int b = 0; b < 2; ++b)
#pragma unroll
            for (int m = 0; m < 4; ++m)
#pragma unroll
                for (int n = 0; n < 2; ++n) acc[a][b][m][n] = (f32x4){0.f, 0.f, 0.f, 0.f};
    bf16x8 At[4][2], B0[2][2], B1[2][2];
    const char* cA = (const char*)g.A + (size_t)cur.pm * tstep; const char* cB = (const char*)g.Bt + (size_t)cur.pn * tstep;
    S.a_ready(cur);
    if constexpr (SP2) {
        PG8_STAGE(PG8_SB(0, 0), cB, voffB); PG8_STAGE(PG8_SB(0, 1), cB + hstep, voffB); PG8_STAGE(PG8_SA(0, 0), cA, voffA); PG8_STAGE(PG8_SA(0, 1), cA + hstep, voffA);
        if (wr == 1) PG8_BAR;
        PG8_WAIT_V(2); PG8_BAR;
        PG8_STAGE(PG8_SB(1, 0), cB + kstep, voffB); PG8_STAGE(PG8_SA(1, 0), cA + kstep, voffA); PG8_STAGE(PG8_SB(1, 1), cB + hstep + kstep, voffB);
        PG8_WAIT_V(6); PG8_BAR;
    } else {
        PG8_STAGE(PG8_SB(0, 0), cB, voffB); PG8_STAGE(PG8_SA(0, 0), cA, voffA); PG8_STAGE(PG8_SB(0, 1), cB + hstep, voffB); PG8_STAGE(PG8_SA(0, 1), cA + hstep, voffA);
        if (wr == 1) PG8_BAR;
        PG8_WAIT_V(4); PG8_BAR;
        PG8_STAGE(PG8_SB(1, 0), cB + kstep, voffB); PG8_STAGE(PG8_SA(1, 0), cA + kstep, voffA); PG8_STAGE(PG8_SB(1, 1), cB + hstep + kstep, voffB);
        PG8_WAIT_V(6); PG8_BAR;
    }
    for (;;) {
        const bool has_next = S.next(ui + 1, nxt);
        const char* nA = has_next ? (const char*)g.A + (size_t)nxt.pm * tstep : cA; const char* nB = has_next ? (const char*)g.Bt + (size_t)nxt.pn * tstep : cB;
        for (int t = 0; t < nt; t += 2) {
            const bool last = (t == nt - 2);
            const char* a1 = cA + (size_t)(t + 1) * kstep;
            const char* a2 = last ? nA : cA + (size_t)(t + 2) * kstep; const char* b2 = last ? nB : cB + (size_t)(t + 2) * kstep;
            const char* a3 = a2 + kstep; const char* b3 = b2 + kstep;
            if (last && has_next) S.a_ready(nxt);
            if constexpr (Hook::ON) { if (t == Hook::T) H.mid(acc, cur, wr, wc, fr, fq); }
            if constexpr (SP2) {
            PG8_LDB(B0, 0, 0); PG8_LDB(B1, 0, 1); PG8_SCHED; PG8_LDA(At, 0, 0); PG8_STAGE(PG8_SA(1, 1), a1 + hstep, voffA);
            PG8_WAIT_V(8); PG8_WAIT_L(0); PG8_BAR; PG8_MMA(0, 0, At, B0); PG8_MMA(0, 1, At, B1); PG8_BAR; PG8_SCHED;
            PG8_LDA(At, 0, 1); PG8_STAGE(PG8_SB(0, 0), b2, voffB); PG8_STAGE(PG8_SB(0, 1), b2 + hstep, voffB); PG8_STAGE(PG8_SA(0, 0), a2, voffA);
            PG8_WAIT_V(8); PG8_WAIT_L(0); PG8_BAR; PG8_MMA(1, 0, At, B0); PG8_MMA(1, 1, At, B1); PG8_BAR; PG8_SCHED;
            PG8_LDB(B0, 1, 0); PG8_LDB(B1, 1, 1); PG8_SCHED; PG8_LDA(At, 1, 0); PG8_STAGE(PG8_SA(0, 1), a2 + hstep, voffA);
            PG8_WAIT_V(8); PG8_WAIT_L(0); PG8_BAR; PG8_MMA(0, 0, At, B0); PG8_MMA(0, 1, At, B1); PG8_BAR; PG8_SCHED;
            PG8_LDA(At, 1, 1); PG8_STAGE(PG8_SB(1, 0), b3, voffB); PG8_STAGE(PG8_SB(1, 1), b3 + hstep, voffB); PG8_STAGE(PG8_SA(1, 0), a3, voffA);
            PG8_WAIT_V(8); PG8_WAIT_L(0); PG8_BAR; PG8_MMA(1, 0, At, B0); PG8_MMA(1, 1, At, B1); PG8_BAR; PG8_SCHED;
            } else {
            PG8_LDB(B0, 0, 0); PG8_SCHED; PG8_LDA(At, 0, 0); PG8_STAGE(PG8_SA(1, 1), a1 + hstep, voffA);
            PG8_WAIT_L(8); PG8_BAR; PG8_WAIT_L(0); PG8_MMA(0, 0, At, B0); PG8_BAR; PG8_SCHED;
            PG8_LDB(B1, 0, 1); PG8_STAGE(PG8_SB(0, 0), b2, voffB);
            PG8_BAR; PG8_WAIT_L(0); PG8_MMA(0, 1, At, B1); PG8_BAR;
            PG8_LDA(At, 0, 1); PG8_STAGE(PG8_SA(0, 0), a2, voffA);
            PG8_BAR; PG8_WAIT_L(0); PG8_MMA(1, 0, At, B0); PG8_BAR; PG8_SCHED;
            PG8_STAGE(PG8_SB(0, 1), b2 + hstep, voffB);
            PG8_WAIT_V(6); PG8_BAR; PG8_MMA(1, 1, At, B1); PG8_BAR;
            PG8_LDB(B0, 1, 0); PG8_SCHED; PG8_LDA(At, 1, 0); PG8_STAGE(PG8_SA(0, 1), a2 + hstep, voffA);
            PG8_WAIT_L(8); PG8_BAR; PG8_WAIT_L(0); PG8_MMA(0, 0, At, B0); PG8_BAR; PG8_SCHED;
            PG8_LDB(B1, 1, 1); PG8_STAGE(PG8_SB(1, 0), b3, voffB);
            PG8_BAR; PG8_WAIT_L(0); PG8_MMA(0, 1, At, B1); PG8_BAR;
            PG8_LDA(At, 1, 1); PG8_STAGE(PG8_SA(1, 0), a3, voffA);
            PG8_BAR; PG8_WAIT_L(0); PG8_MMA(1, 0, At, B0); PG8_BAR; PG8_SCHED;
            PG8_STAGE(PG8_SB(1, 1), b3 + hstep, voffB);
            PG8_WAIT_V(6); PG8_BAR; PG8_MMA(1, 1, At, B1); PG8_BAR;
            }
        }
        if constexpr (ALIGN_EPI) { if (wr == 0) PG8_BAR; }
        if constexpr (!Epi::AFTER_DRAIN) { E(acc, cur, wr, wc, fr, fq); S.done(cur); }
        if (!has_next) break;
#pragma unroll
        for (int a = 0; a < 2; ++a)
#pragma unroll
            for (int b = 0; b < 2; ++b)
#pragma unroll
                for (int m = 0; m < 4; ++m)
#pragma unroll
                    for (int n = 0; n < 2; ++n) acc[a][b][m][n] = (f32x4){0.f, 0.f, 0.f, 0.f};
        cur = nxt; cA = nA; cB = nB; ++ui;
        if constexpr (ALIGN_EPI) { if (wr == 1) PG8_BAR; }
    }
    PG8_WAIT_V(0);
    if constexpr (!ALIGN_EPI) { if (wr == 0) PG8_BAR; }
    PG8_BAR;
    if constexpr (Epi::AFTER_DRAIN) { E.fused(acc, cur, wr, wc, fr, fq, lds, wid, lane); S.done(cur); }
#undef PG8_SA
#undef PG8_SB
#undef PG8_STAGE
#undef PG8_LDA
#undef PG8_LDB
#undef PG8_MMA
#undef PG8_WAIT_V
#undef PG8_WAIT_L
#undef PG8_BAR
#undef PG8_SCHED
}
}

namespace cg = cooperative_groups;
#ifndef PROBE_DUP
#define PROBE_DUP -1
#endif
#ifndef PROBE_DRY
#define PROBE_DRY 0
#endif
#ifndef STATIC_PLAN
#define STATIC_PLAN 0
#endif
#define LAS __attribute__((address_space(3)))
typedef unsigned short bf16_t;
typedef short bf16x8 __attribute__((ext_vector_type(8)));
typedef short s16x4 __attribute__((ext_vector_type(4)));
typedef float f32x4 __attribute__((ext_vector_type(4)));
typedef float f32x16 __attribute__((ext_vector_type(16)));
typedef unsigned u32x4 __attribute__((ext_vector_type(4)));
typedef unsigned u32x2 __attribute__((ext_vector_type(2)));

constexpr int DM = 2048, NB = 2, SEQ = 4096, MTOK = NB * SEQ;
constexpr int INW = 11328, INWP = 11520;
constexpr float EPS = 1e-6f;
constexpr float LOG2E = 1.4426950408889634f;
constexpr float QS_MLA = 0.07216878364870322f * LOG2E;
constexpr float QS_DIF = 0.125f * LOG2E;
constexpr float LAMBDA_INIT = 0.2f;

constexpr size_t MiB = 1u << 20;
constexpr size_t WS_CTL = 0;
constexpr size_t CTL_BYTES = 1 * MiB;
constexpr size_t WS_ROPE = 2 * MiB;
constexpr size_t WS_WUKV = 4 * MiB, WS_WOM = 6 * MiB, WS_WOD = 10 * MiB, WS_WOUT = 14 * MiB, WS_WIN = 22 * MiB;
constexpr size_t WS_H = 67 * MiB;
constexpr size_t WS_QM = 99 * MiB, WS_CKV = 123 * MiB, WS_KM = 131 * MiB, WS_VM = 155 * MiB;
constexpr size_t WS_QD = 171 * MiB, WS_KD = 187 * MiB, WS_VD = 203 * MiB, WS_GM = 219 * MiB, WS_GD = 235 * MiB;
constexpr size_t WS_SM = 251 * MiB, WS_SD = 283 * MiB, WS_OA = 315 * MiB, WS_END = 347 * MiB;
constexpr size_t WS_Y = 99 * MiB;
constexpr int CTL_BAR = 32768;
constexpr int CTL_SSQC = 0, CTL_SSQY = 8192, CTL_ADA = 16384, CTL_QUEUE = 16384 + 12288;

constexpr int LDS_MAIN = 131072, LDS_MISC = 131072, LDS_BYTES = 135168;

__device__ __forceinline__ unsigned f2bf(float f) { unsigned u = __builtin_bit_cast(unsigned, f); return (u + 0x7fffu + ((u >> 16) & 1u)) >> 16; }
typedef float f32x2_t __attribute__((ext_vector_type(2))); typedef __bf16 bf16x2_t __attribute__((ext_vector_type(2)));
__device__ __forceinline__ unsigned pk2(float lo, float hi) { f32x2_t v = {lo, hi}; bf16x2_t b = __builtin_convertvector(v, bf16x2_t); return __builtin_bit_cast(unsigned, b); }
__device__ __forceinline__ float fexp2(float v) { return __builtin_amdgcn_exp2f(v); }
__device__ __forceinline__ float bf2f(unsigned short b) { return __builtin_bit_cast(float, (unsigned)b << 16); }
__device__ __forceinline__ float bflo(unsigned w) { return __builtin_bit_cast(float, w << 16); }
__device__ __forceinline__ float bfhi(unsigned w) { return __builtin_bit_cast(float, w & 0xffff0000u); }
__device__ __forceinline__ float wave_sum(float v) {
#pragma unroll
    for (int o = 1; o < 64; o <<= 1) v += __shfl_xor(v, o);
    return v;
}
__device__ __forceinline__ float fsigmoid(float v) { return __builtin_amdgcn_rcpf(1.0f + fexp2(-1.4426950408889634f * v)); }

__device__ __forceinline__ int vsrc_in(int v) {
    if (v < 1536) { const int hd = v / 192, w = v - hd * 192; if (w < 128) return v; const int r = w - 128; return hd * 192 + 128 + (r >> 1) + 32 * (r & 1); }
    if (v < 2048) return v;
    if (v < 11264) return v + 64;
    if (v < 11328) { const int r = v - 11264; return 2048 + (r >> 1) + 32 * (r & 1); }
    return -1;
}

namespace epi {
using pg8::Unit;
__device__ __forceinline__ void st8(bf16_t* p, f32x4 a, f32x4 b) {
    u32x4 w; w.x = pk2(a[0], a[1]); w.y = pk2(a[2], a[3]); w.z = pk2(b[0], b[1]); w.w = pk2(b[2], b[3]); *(u32x4*)p = w;
}
__device__ __forceinline__ void rope8(f32x4& v0, f32x4& v1, const float* rc, const float* rs) {
    const f32x4 c4 = *(const f32x4*)rc, s4 = *(const f32x4*)rs;
    f32x4 a, b;
    a[0] = v0[0] * c4[0] - v0[1] * s4[0]; a[1] = v0[1] * c4[0] + v0[0] * s4[0];
    a[2] = v0[2] * c4[1] - v0[3] * s4[1]; a[3] = v0[3] * c4[1] + v0[2] * s4[1];
    b[0] = v1[0] * c4[2] - v1[1] * s4[2]; b[1] = v1[1] * c4[2] + v1[0] * s4[2];
    b[2] = v1[2] * c4[3] - v1[3] * s4[3]; b[3] = v1[3] * c4[3] + v1[2] * s4[3];
    v0 = a; v1 = b;
}
template <int ACT> __device__ __forceinline__ void store_tile(const f32x4 (&acc)[2][2][4][2], bf16_t* dst, int ldc, int colt, int rowb, int colw, float sc) {
#pragma unroll
    for (int ai = 0; ai < 2; ++ai)
#pragma unroll
        for (int m = 0; m < 4; ++m) { bf16_t* rowp = dst + (size_t)(rowb + ai * 128 + m * 16) * ldc + colt + colw;
#pragma unroll
            for (int bj = 0; bj < 2; ++bj) { f32x4 v0 = acc[ai][bj][m][0], v1 = acc[ai][bj][m][1];
                if (ACT == 1) { v0 = v0 * sc; v1 = v1 * sc; }
                if (ACT == 2) {
#pragma unroll
                    for (int i = 0; i < 4; ++i) { v0[i] = v0[i] * fsigmoid(v0[i]); v1[i] = v1[i] * fsigmoid(v1[i]); } }
                if (ACT == 3) {
#pragma unroll
                    for (int i = 0; i < 4; ++i) { v0[i] = fsigmoid(v0[i]); v1[i] = fsigmoid(v1[i]); } }
                st8(rowp + bj * 128, v0, v1); } }
}

struct EpiProj {
    static constexpr bool PERM = true, AFTER_DRAIN = false;
    bf16_t *QM, *CKV, *QD, *KD, *VD, *GM, *GD, *SM, *SD, *KM; float* ssq; const float* rc; const float* rs;
    __device__ __forceinline__ void operator()(const f32x4 (&acc)[2][2][4][2], const Unit& u, int wr, int wc, int fr, int fq) const {
        const int pn = u.pn, rowb = u.pm * 256 + wr * 64 + fr, colw = wc * 32 + 8 * fq;
        if (pn < 6) {
#pragma unroll
            for (int bj = 0; bj < 2; ++bj) { const int col = pn * 256 + bj * 128 + colw, w = col % 192; const bool rp = w >= 128; const int i0 = (w - 128) >> 1;
#pragma unroll
                for (int ai = 0; ai < 2; ++ai)
#pragma unroll
                    for (int m = 0; m < 4; ++m) { const int row = rowb + ai * 128 + m * 16; f32x4 v0 = acc[ai][bj][m][0], v1 = acc[ai][bj][m][1];
                        if (rp) rope8(v0, v1, rc + (size_t)row * 32 + i0, rs + (size_t)row * 32 + i0);
                        v0 = v0 * QS_MLA; v1 = v1 * QS_MLA; st8(QM + (size_t)row * 1536 + col, v0, v1); } }
        } else if (pn < 8) {
            const int colt = (pn - 6) * 256;
#pragma unroll
            for (int ai = 0; ai < 2; ++ai)
#pragma unroll
                for (int m = 0; m < 4; ++m) { const int row = rowb + ai * 128 + m * 16; float s = 0.f;
#pragma unroll
                    for (int bj = 0; bj < 2; ++bj) { const f32x4 v0 = acc[ai][bj][m][0], v1 = acc[ai][bj][m][1];
                        s += (v0[0] * v0[0] + v0[1] * v0[1]) + (v0[2] * v0[2] + v0[3] * v0[3]) + (v1[0] * v1[0] + v1[1] * v1[1]) + (v1[2] * v1[2] + v1[3] * v1[3]);
                        st8(CKV + (size_t)row * 512 + colt + bj * 128 + colw, v0, v1); }
                    s += __shfl_xor(s, 16); s += __shfl_xor(s, 32);
                    if (fq == 0) atomicAdd(ssq + row, s); }
        } else if (pn < 12) store_tile<1>(acc, QD, 1024, (pn - 8) * 256, rowb, colw, QS_DIF);
        else if (pn < 16) store_tile<0>(acc, KD, 1024, (pn - 12) * 256, rowb, colw, 1.f);
        else if (pn < 20) store_tile<0>(acc, VD, 1024, (pn - 16) * 256, rowb, colw, 1.f);
        else if (pn < 24) store_tile<2>(acc, GM, 1024, (pn - 20) * 256, rowb, colw, 1.f);
        else if (pn < 28) store_tile<2>(acc, GD, 1024, (pn - 24) * 256, rowb, colw, 1.f);
        else if (pn < 36) store_tile<3>(acc, SM, 2048, (pn - 28) * 256, rowb, colw, 1.f);
        else if (pn < 44) store_tile<3>(acc, SD, 2048, (pn - 36) * 256, rowb, colw, 1.f);
        else {
            if (wc < 2) { const int i0 = colw >> 1;
#pragma unroll
                for (int ai = 0; ai < 2; ++ai)
#pragma unroll
                    for (int m = 0; m < 4; ++m) { const int row = rowb + ai * 128 + m * 16; f32x4 v0 = acc[ai][0][m][0], v1 = acc[ai][0][m][1];
                        rope8(v0, v1, rc + (size_t)row * 32 + i0, rs + (size_t)row * 32 + i0);
                        const int b = row >> 12, s = row & 4095;
#pragma unroll
                        for (int h = 0; h < 8; ++h) st8(KM + ((size_t)(b * 8 + h) * SEQ + s) * 192 + 128 + colw, v0, v1); } }
        }
    }
};
struct EpiUp {
    static constexpr bool PERM = true, AFTER_DRAIN = false;
    bf16_t *KM, *VM; const float* ssq;
    __device__ __forceinline__ void operator()(const f32x4 (&acc)[2][2][4][2], const Unit& u, int wr, int wc, int fr, int fq) const {
        const int h = u.pn, rowb = u.pm * 256 + wr * 64 + fr, colw = wc * 32 + 8 * fq;
#pragma unroll
        for (int ai = 0; ai < 2; ++ai)
#pragma unroll
            for (int m = 0; m < 4; ++m) { const int row = rowb + ai * 128 + m * 16; const float r = rsqrtf(ssq[row] * (1.0f / 512.0f) + EPS);
                const int b = row >> 12, s = row & 4095;
                st8(KM + ((size_t)(b * 8 + h) * SEQ + s) * 192 + colw, acc[ai][0][m][0] * r, acc[ai][0][m][1] * r);
                st8(VM + (size_t)row * 1024 + h * 128 + colw, acc[ai][1][m][0] * r, acc[ai][1][m][1] * r); }
    }
};
struct EpiO1 {
    static constexpr bool PERM = true, AFTER_DRAIN = false;
    bf16_t* Y; const bf16_t* S;
    __device__ __forceinline__ void operator()(const f32x4 (&acc)[2][2][4][2], const Unit& u, int wr, int wc, int fr, int fq) const {
        const int rowb = u.pm * 256 + wr * 64 + fr, colb = u.pn * 256 + wc * 32 + 8 * fq;
#pragma unroll
        for (int ai = 0; ai < 2; ++ai)
#pragma unroll
            for (int m = 0; m < 4; ++m)
#pragma unroll
                for (int bj = 0; bj < 2; ++bj) { const size_t off = (size_t)(rowb + ai * 128 + m * 16) * DM + colb + bj * 128;
                    const u32x4 g = *(const u32x4*)(S + off); f32x4 v0 = acc[ai][bj][m][0], v1 = acc[ai][bj][m][1];
                    v0[0] *= bflo(g.x); v0[1] *= bfhi(g.x); v0[2] *= bflo(g.y); v0[3] *= bfhi(g.y); v1[0] *= bflo(g.z); v1[1] *= bfhi(g.z); v1[2] *= bflo(g.w); v1[3] *= bfhi(g.w);
                    st8(Y + off, v0, v1); }
    }
};
struct EpiO2 {
    static constexpr bool PERM = true, AFTER_DRAIN = false;
    const bf16_t* Y; const bf16_t* S; bf16_t* MG;
    __device__ __forceinline__ void operator()(const f32x4 (&acc)[2][2][4][2], const Unit& u, int wr, int wc, int fr, int fq) const {
        const int rowb = u.pm * 256 + wr * 64 + fr, colb = u.pn * 256 + wc * 32 + 8 * fq;
#pragma unroll
        for (int ai = 0; ai < 2; ++ai)
#pragma unroll
            for (int m = 0; m < 4; ++m)
#pragma unroll
                for (int bj = 0; bj < 2; ++bj) { const size_t off = (size_t)(rowb + ai * 128 + m * 16) * DM + colb + bj * 128;
                    const u32x4 g = *(const u32x4*)(S + off); f32x4 v0 = acc[ai][bj][m][0], v1 = acc[ai][bj][m][1];
                    const u32x4 yy = *(const u32x4*)(Y + off); const f32x4 y0 = {bflo(yy.x), bfhi(yy.x), bflo(yy.y), bfhi(yy.y)}, y1 = {bflo(yy.z), bfhi(yy.z), bflo(yy.w), bfhi(yy.w)};
                    v0[0] = y0[0] + v0[0] * bflo(g.x); v0[1] = y0[1] + v0[1] * bfhi(g.x); v0[2] = y0[2] + v0[2] * bflo(g.y); v0[3] = y0[3] + v0[3] * bfhi(g.y);
                    v1[0] = y1[0] + v1[0] * bflo(g.z); v1[1] = y1[1] + v1[1] * bfhi(g.z); v1[2] = y1[2] + v1[2] * bflo(g.w); v1[3] = y1[3] + v1[3] * bfhi(g.w);
                    st8(MG + off, v0, v1); }
    }
};
struct HookMerge {
    static constexpr bool ON = true; static constexpr int T = 16;
    const bf16_t *SMp, *SDp;
    __device__ __forceinline__ void mid(f32x4 (&acc)[2][2][4][2], const Unit& u, int wr, int wc, int fr, int fq) const {
        int rowb = u.pm * 256 + wr * 64 + fr, colb = u.pn * 256 + wc * 32 + 8 * fq;
        asm volatile("" : "+v"(rowb), "+v"(colb));
#pragma unroll
        for (int ai = 0; ai < 2; ++ai)
#pragma unroll
            for (int m = 0; m < 4; ++m) {
#pragma unroll
                for (int bj = 0; bj < 2; ++bj) { const size_t off = (size_t)(rowb + ai * 128 + m * 16) * DM + colb + bj * 128;
                    const u32x4 a = *(const u32x4*)(SMp + off), d = *(const u32x4*)(SDp + off);
                    f32x4 r0, r1;
                    r0[0] = bflo(a.x) * __builtin_amdgcn_rcpf(bflo(d.x)); r0[1] = bfhi(a.x) * __builtin_amdgcn_rcpf(bfhi(d.x)); r0[2] = bflo(a.y) * __builtin_amdgcn_rcpf(bflo(d.y)); r0[3] = bfhi(a.y) * __builtin_amdgcn_rcpf(bfhi(d.y));
                    r1[0] = bflo(a.z) * __builtin_amdgcn_rcpf(bflo(d.z)); r1[1] = bfhi(a.z) * __builtin_amdgcn_rcpf(bfhi(d.z)); r1[2] = bflo(a.w) * __builtin_amdgcn_rcpf(bflo(d.w)); r1[3] = bfhi(a.w) * __builtin_amdgcn_rcpf(bfhi(d.w));
                    acc[ai][bj][m][0] = acc[ai][bj][m][0] * r0; acc[ai][bj][m][1] = acc[ai][bj][m][1] * r1; }
                if (m & 1) asm volatile("" ::: "memory");
            }
    }
};
struct EpiMerge {
    static constexpr bool PERM = true, AFTER_DRAIN = false;
    const bf16_t* S; bf16_t* MG;
    __device__ __forceinline__ void operator()(const f32x4 (&acc)[2][2][4][2], const Unit& u, int wr, int wc, int fr, int fq) const {
        const int rowb = u.pm * 256 + wr * 64 + fr, colb = u.pn * 256 + wc * 32 + 8 * fq;
#pragma unroll
        for (int ai = 0; ai < 2; ++ai)
#pragma unroll
            for (int m = 0; m < 4; ++m)
#pragma unroll
                for (int bj = 0; bj < 2; ++bj) { const size_t off = (size_t)(rowb + ai * 128 + m * 16) * DM + colb + bj * 128;
                    const u32x4 g = *(const u32x4*)(S + off); f32x4 v0 = acc[ai][bj][m][0], v1 = acc[ai][bj][m][1];
                    v0[0] *= bflo(g.x); v0[1] *= bfhi(g.x); v0[2] *= bflo(g.y); v0[3] *= bfhi(g.y); v1[0] *= bflo(g.z); v1[1] *= bfhi(g.z); v1[2] *= bflo(g.w); v1[3] *= bfhi(g.w);
                    st8(MG + off, v0, v1); }
    }
};
struct EpiOut {
    static constexpr bool PERM = true, AFTER_DRAIN = false;
    bf16_t* Y; float* ssq;
    __device__ __forceinline__ void operator()(const f32x4 (&acc)[2][2][4][2], const Unit& u, int wr, int wc, int fr, int fq) const {
        const int rowb = u.pm * 256 + wr * 64 + fr, colb = u.pn * 256 + wc * 32 + 8 * fq;
#pragma unroll
        for (int ai = 0; ai < 2; ++ai)
#pragma unroll
            for (int m = 0; m < 4; ++m) { const int row = rowb + ai * 128 + m * 16; float s = 0.f;
#pragma unroll
                for (int bj = 0; bj < 2; ++bj) { const size_t off = (size_t)row * DM + colb + bj * 128; const f32x4 v0 = acc[ai][bj][m][0], v1 = acc[ai][bj][m][1];
                    s += (v0[0] * v0[0] + v0[1] * v0[1]) + (v0[2] * v0[2] + v0[3] * v0[3]) + (v1[0] * v1[0] + v1[1] * v1[1]) + (v1[2] * v1[2] + v1[3] * v1[3]);
                    st8(Y + off, v0, v1); }
                s += __shfl_xor(s, 16); s += __shfl_xor(s, 32);
                if (fq == 0) atomicAdd(ssq + row, s); }
    }
};
}

namespace att {
constexpr int KBUF = 25600, VBUF = 20480, VROW = 320;
constexpr int OFF_K = 0, OFF_V = 2 * KBUF, OFF_POS = OFF_V + 2 * VBUF, OFF_WSF = OFF_POS + 512, OFF_END = OFF_WSF + 8 * 256;
static_assert(OFF_END <= LDS_MAIN, "attention LDS");
constexpr float NEG = -1e30f;
struct Ptrs { const bf16_t *QM, *KM, *VM, *QD, *KD, *VD, *GM, *GD; bf16_t *OM, *OD; const int* pos; const float* gsub; float lam; };
__device__ __forceinline__ int crow(int r, int hi) { return (r & 3) + 8 * (r >> 2) + 4 * hi; }
__device__ __forceinline__ float xmax(float v) { const unsigned u = __float_as_uint(v); auto rr = __builtin_amdgcn_permlane32_swap(u, u, false, false); return fmaxf(__uint_as_float(rr[0]), __uint_as_float(rr[1])); }
__device__ __forceinline__ float xsum(float v) { const unsigned u = __float_as_uint(v); auto rr = __builtin_amdgcn_permlane32_swap(u, u, false, false); return __uint_as_float(rr[0]) + __uint_as_float(rr[1]); }
__device__ __forceinline__ s16x4 vtr(const LAS unsigned char* p) { return __builtin_bit_cast(s16x4, __builtin_amdgcn_ds_read_tr16_b64_v4i16((LAS s16x4*)p)); }
__device__ __forceinline__ bf16x8 pack8(const f32x16& p, int s) {
    u32x4 w; w.x = pk2(p[8 * s + 0], p[8 * s + 1]); w.y = pk2(p[8 * s + 2], p[8 * s + 3]); w.z = pk2(p[8 * s + 4], p[8 * s + 5]); w.w = pk2(p[8 * s + 6], p[8 * s + 7]);
    return __builtin_bit_cast(bf16x8, w);
}

template <bool MLA> __device__ __forceinline__ void attn_unit(LAS unsigned char* lds, const int b, const int h, const int qb, const Ptrs& P, const int dry) {
    constexpr int ROWS = MLA ? 256 : 128, DK = MLA ? 192 : 64, DKT = MLA ? 192 : 128, KROW = DKT * 2 + 16, CPR = DKT / 8, KCH = (64 * CPR) / 512, ND = DK / 16;
    int tid_ = threadIdx.x; asm volatile("" : "+v"(tid_));
    const int tid = tid_, lane = tid & 63, wid = __builtin_amdgcn_readfirstlane(tid >> 6), r32 = lane & 31, hi = lane >> 5;
    const int rg = MLA ? wid : (wid >> 1), c = MLA ? 0 : (wid & 1);
    const int q0 = qb * ROWS, q0w = q0 + 32 * rg, qabs = q0w + r32;
    const size_t tokb = (size_t)b * SEQ;
    const bf16_t* Kg = MLA ? P.KM + ((size_t)(b * 8 + h) * SEQ) * 192 : P.KD + tokb * 1024 + h * 128;
    constexpr int KLD = MLA ? 192 : 1024;
    const bf16_t* Vg = (MLA ? P.VM : P.VD) + tokb * 1024 + h * 128;
    bf16x8 qf[ND];
    { const bf16_t* Qg = MLA ? P.QM + (tokb + qabs) * 1536 + h * 192 : P.QD + (tokb + qabs) * 1024 + h * 128 + c * 64;
#pragma unroll
      for (int d0 = 0; d0 < ND; ++d0) qf[d0] = *(const bf16x8*)(Qg + d0 * 16 + hi * 8); }
    float posq = 0.f, slope2 = 0.f;
    if (!MLA) { posq = (float)P.pos[tokb + qabs]; slope2 = exp2f(-(float)(h + 1)) * LOG2E; }
#pragma unroll
    for (int d0 = 0; d0 < ND; ++d0) asm volatile("" : "+v"(qf[d0]));
    asm volatile("" : "+v"(posq), "+v"(slope2));
    u32x4 kreg[KCH], vreg[2]; float preg = 0.f;
    int krow[KCH], kch[KCH], vrow[2], vch[2];
#pragma unroll
    for (int i = 0; i < KCH; ++i) { const int idx = tid + 512 * i; krow[i] = idx / CPR; kch[i] = idx % CPR; }
#pragma unroll
    for (int i = 0; i < 2; ++i) { const int idx = tid + 512 * i; vrow[i] = idx >> 4; vch[i] = idx & 15; }
#define ATT_LOAD(j) do { const int kv0_ = 64 * (j); \
        _Pragma("unroll") for (int i = 0; i < KCH; ++i) kreg[i] = *(const u32x4*)(Kg + (size_t)(kv0_ + krow[i]) * KLD + kch[i] * 8); \
        _Pragma("unroll") for (int i = 0; i < 2; ++i) vreg[i] = *(const u32x4*)(Vg + (size_t)(kv0_ + vrow[i]) * 1024 + vch[i] * 8); \
        if (!MLA) { if (tid < 64) preg = (float)P.pos[tokb + kv0_ + tid]; } } while (0)
#define ATT_WRITE(bf) do { \
        _Pragma("unroll") for (int i = 0; i < KCH; ++i) *(LAS u32x4*)(lds + OFF_K + (bf) * KBUF + krow[i] * KROW + kch[i] * 16) = kreg[i]; \
        _Pragma("unroll") for (int i = 0; i < 2; ++i) *(LAS u32x4*)(lds + OFF_V + (bf) * VBUF + vrow[i] * VROW + vch[i] * 16) = vreg[i]; \
        if (!MLA) { if (tid < 64) *(LAS float*)(lds + OFF_POS + (bf) * 256 + tid * 4) = preg; } } while (0)

    LAS float* wsf = (LAS float*)(lds + OFF_WSF + wid * 256);
    f32x16 o[4];
#pragma unroll
    for (int d = 0; d < 4; ++d)
#pragma unroll
        for (int r = 0; r < 16; ++r) o[d][r] = 0.f;
    float mrun = NEG, lrun = 0.f;
    const int NT = (q0 + ROWS) / 64;
    const int kbase = (r32)*KROW + c * 128 + hi * 16;
    const int vbase = (4 * hi + ((lane & 15) >> 2)) * VROW + (((lane >> 4) & 1) * 16 + (lane & 3) * 4) * 2;

    ATT_LOAD(0);
    __syncthreads();
    ATT_WRITE(0);
    for (int j = 0; j < NT; ++j) {
        const int bf = j & 1;
        if (j + 1 < NT && !(dry & 4)) ATT_LOAD(j + 1);
        __syncthreads();
        const int kv0 = 64 * j;
#pragma unroll 1
        for (int kvh = 0; kvh < 2; ++kvh) {
            const int kvs = kv0 + 32 * kvh;
            if (kvs > q0w + 31 || (dry & 1) || ((dry & 8) && (wid & 4))) break;
            const LAS unsigned char* Kb = lds + OFF_K + bf * KBUF + kbase + kvh * 32 * KROW;
            bf16x8 kf[ND];
#pragma unroll
            for (int d0 = 0; d0 < ND; ++d0) kf[d0] = *(const LAS bf16x8*)(Kb + d0 * 32);
            __builtin_amdgcn_sched_barrier(0);
            f32x16 p;
#pragma unroll
            for (int r = 0; r < 16; ++r) p[r] = 0.f;
#pragma unroll
            for (int d0 = 0; d0 < ND; ++d0) p = __builtin_amdgcn_mfma_f32_32x32x16_bf16(kf[d0], qf[d0], p, 0, 0, 0);
            __builtin_amdgcn_sched_barrier(0);
            const LAS unsigned char* Vb = lds + OFF_V + bf * VBUF + vbase + kvh * 32 * VROW;
            s16x4 vlo[8], vhi[8];
#pragma unroll
            for (int s2 = 0; s2 < 2; ++s2)
#pragma unroll
                for (int db = 0; db < 4; ++db) { vlo[s2 * 4 + db] = vtr(Vb + s2 * 16 * VROW + db * 64); vhi[s2 * 4 + db] = vtr(Vb + s2 * 16 * VROW + 8 * VROW + db * 64); }
            __builtin_amdgcn_sched_barrier(0);
            if (!MLA) {
                const LAS float* pp = (const LAS float*)(lds + OFF_POS + bf * 256) + 32 * kvh + 4 * hi;
#pragma unroll
                for (int g = 0; g < 4; ++g) { const f32x4 a = *(const LAS f32x4*)(pp + 8 * g);
#pragma unroll
                    for (int i = 0; i < 4; ++i) p[4 * g + i] -= slope2 * fabsf(posq - a[i]); }
            }
            if (kvs + 31 > q0w) {
#pragma unroll
                for (int r = 0; r < 16; ++r) { if (kvs + crow(r, hi) > qabs) p[r] = NEG; }
            }
            float mx;
            { const float m0 = fmaxf(fmaxf(p[0], p[1]), fmaxf(p[2], p[3])), m1 = fmaxf(fmaxf(p[4], p[5]), fmaxf(p[6], p[7]));
              const float m2 = fmaxf(fmaxf(p[8], p[9]), fmaxf(p[10], p[11])), m3 = fmaxf(fmaxf(p[12], p[13]), fmaxf(p[14], p[15]));
              mx = fmaxf(fmaxf(m0, m1), fmaxf(m2, m3)); }
            mx = xmax(mx);
            const float mnew = fmaxf(mrun, mx), alpha = fexp2(mrun - mnew);
            mrun = mnew;
            float rs0 = 0.f, rs1 = 0.f, rs2 = 0.f, rs3 = 0.f;
#pragma unroll
            for (int r = 0; r < 16; r += 4) { p[r] = fexp2(p[r] - mnew); p[r + 1] = fexp2(p[r + 1] - mnew); p[r + 2] = fexp2(p[r + 2] - mnew); p[r + 3] = fexp2(p[r + 3] - mnew);
                rs0 += p[r]; rs1 += p[r + 1]; rs2 += p[r + 2]; rs3 += p[r + 3]; }
            lrun = lrun * alpha + ((rs0 + rs1) + (rs2 + rs3));
            if (__any(alpha != 1.0f)) {
                if (hi == 0) wsf[r32] = alpha;
#pragma unroll
                for (int g = 0; g < 4; ++g) { const f32x4 a4 = *(const LAS f32x4*)(wsf + 8 * g + 4 * hi);
#pragma unroll
                    for (int d = 0; d < 4; ++d)
#pragma unroll
                        for (int i = 0; i < 4; ++i) o[d][4 * g + i] *= a4[i]; }
            }
            __builtin_amdgcn_sched_barrier(0);
#pragma unroll
            for (int s2 = 0; s2 < 2; ++s2) {
                const bf16x8 pa = pack8(p, s2);
#pragma unroll
                for (int db = 0; db < 4; ++db) {
                    const s16x4 lo = vlo[s2 * 4 + db], hh = vhi[s2 * 4 + db];
                    const bf16x8 vb = (bf16x8){lo[0], lo[1], lo[2], lo[3], hh[0], hh[1], hh[2], hh[3]};
                    o[db] = __builtin_amdgcn_mfma_f32_32x32x16_bf16(pa, vb, o[db], 0, 0, 0);
                }
            }
        }
        if (j + 1 < NT && !(dry & 4)) ATT_WRITE(bf ^ 1);
    }
#undef ATT_LOAD
#undef ATT_WRITE
    int q0e = q0w, r32e = r32, hie = hi; asm volatile("" : "+s"(q0e), "+v"(r32e), "+v"(hie));
    if (dry) { if (dry & 1) asm volatile("" :: "v"(qf[0]), "v"(qf[ND - 1])); else asm volatile("" :: "v"(o[0]), "v"(o[1]), "v"(o[2]), "v"(o[3]), "v"(lrun)); return; }
    float lt = xsum(lrun);
    if (hie == 0) wsf[32 + r32e] = 1.0f / lt;
    f32x4 li[4];
#pragma unroll
    for (int g = 0; g < 4; ++g) li[g] = *(const LAS f32x4*)(wsf + 32 + 8 * g + 4 * hie);
    constexpr int SROW = 272;
    if (MLA) {
        __syncthreads();
        LAS unsigned char* stg = lds + wid * (32 * SROW);
#pragma unroll
        for (int r = 0; r < 16; ++r)
#pragma unroll
            for (int db = 0; db < 4; ++db) *(LAS bf16_t*)(stg + crow(r, hie) * SROW + (32 * db + r32e) * 2) = (bf16_t)f2bf(o[db][r] * li[r >> 2][r & 3]);
        asm volatile("s_waitcnt lgkmcnt(0)" ::: "memory");
#pragma unroll
        for (int i = 0; i < 8; ++i) { const int idx = i * 64 + lane, row = idx >> 4, ch = idx & 15;
            const u32x4 ov = *(const LAS u32x4*)(stg + row * SROW + ch * 16);
            const size_t off = (tokb + q0e + row) * 1024 + h * 128 + ch * 8, offo = (tokb + q0e + row) * 2048 + h * 128 + ch * 8;
            const u32x4 g = *(const u32x4*)(P.GM + off);
            u32x4 w; w.x = pk2(bflo(ov.x) * bflo(g.x), bfhi(ov.x) * bfhi(g.x)); w.y = pk2(bflo(ov.y) * bflo(g.y), bfhi(ov.y) * bfhi(g.y));
            w.z = pk2(bflo(ov.z) * bflo(g.z), bfhi(ov.z) * bfhi(g.z)); w.w = pk2(bflo(ov.w) * bflo(g.w), bfhi(ov.w) * bfhi(g.w));
            *(u32x4*)(P.OM + offo) = w; }
    } else {
        LAS float* comb = (LAS float*)lds;
        __syncthreads();
        if (c == 1) {
#pragma unroll
            for (int r = 0; r < 16; ++r)
#pragma unroll
                for (int db = 0; db < 4; ++db) comb[((rg * 16 + r) * 2 + hie) * 128 + db * 32 + r32e] = o[db][r] * li[r >> 2][r & 3];
        }
        __syncthreads();
        if (c == 0) {
            float gs[4];
#pragma unroll
            for (int db = 0; db < 4; ++db) gs[db] = P.gsub[32 * db + r32e] * (1.0f - LAMBDA_INIT);
#pragma unroll
            for (int r = 0; r < 16; ++r)
#pragma unroll
                for (int db = 0; db < 4; ++db) o[db][r] = o[db][r] * li[r >> 2][r & 3] - P.lam * comb[((rg * 16 + r) * 2 + hie) * 128 + db * 32 + r32e];
            asm volatile("s_waitcnt lgkmcnt(0)" ::: "memory");
            LAS unsigned char* stg = lds + rg * 16384;
#pragma unroll
            for (int r = 0; r < 16; ++r) { float ss = 0.f;
#pragma unroll
                for (int db = 0; db < 4; ++db) ss += o[db][r] * o[db][r];
                ss += __shfl_xor(ss, 1); ss += __shfl_xor(ss, 2); ss += __shfl_xor(ss, 4); ss += __shfl_xor(ss, 8); ss += __shfl_xor(ss, 16);
                const float rstd = rsqrtf(ss * (1.0f / 128.0f) + EPS);
#pragma unroll
                for (int db = 0; db < 4; ++db) *(LAS bf16_t*)(stg + crow(r, hie) * SROW + (32 * db + r32e) * 2) = (bf16_t)f2bf(o[db][r] * rstd * gs[db]); }
            asm volatile("s_waitcnt lgkmcnt(0)" ::: "memory");
#pragma unroll
            for (int i = 0; i < 8; ++i) { const int idx = i * 64 + lane, row = idx >> 4, ch = idx & 15;
                const u32x4 ov = *(const LAS u32x4*)(stg + row * SROW + ch * 16);
                const size_t off = (tokb + q0e + row) * 1024 + h * 128 + ch * 8, offo = (tokb + q0e + row) * 2048 + 1024 + h * 128 + ch * 8;
                const u32x4 g = *(const u32x4*)(P.GD + off);
                u32x4 w; w.x = pk2(bflo(ov.x) * bflo(g.x), bfhi(ov.x) * bfhi(g.x)); w.y = pk2(bflo(ov.y) * bflo(g.y), bfhi(ov.y) * bfhi(g.y));
                w.z = pk2(bflo(ov.z) * bflo(g.z), bfhi(ov.z) * bfhi(g.z)); w.w = pk2(bflo(ov.w) * bflo(g.w), bfhi(ov.w) * bfhi(g.w));
                *(u32x4*)(P.OD + offo) = w; }
        }
    }
}
}

#define XB_TMO      128
#define XB_XCNT(j)  (256  + 64 * (j))
#define XB_XSUB(j)  (1280 + 64 * (j))
#define XB_XGEN(j)  (2304 + 64 * (j))
#define XB_TOP      3328
#define XB_TOPGEN   3392
#define XCD_BAR_WORDS 3456
#define XB_SPIN_CAP (1u << 18)

__device__ __forceinline__ unsigned xb_ld(unsigned* p)              { return __hip_atomic_load(p, __ATOMIC_RELAXED, __HIP_MEMORY_SCOPE_AGENT); }
__device__ __forceinline__ unsigned xb_add(unsigned* p, unsigned v) { return __hip_atomic_fetch_add(p, v, __ATOMIC_RELAXED, __HIP_MEMORY_SCOPE_AGENT); }
__device__ __forceinline__ unsigned xb_xcc_id() { return (unsigned)__builtin_amdgcn_s_getreg((3 << 11) | 20) & 0xFu; }
#define XB_SPIN(cond, bar) do { unsigned _sp = 0; while (cond) { __builtin_amdgcn_s_sleep(1); \
    if ((++_sp & 255u) == 0u) { if (xb_ld(&(bar)[XB_TMO])) break; if (_sp > XB_SPIN_CAP) { atomicAdd(&(bar)[XB_TMO], 1u); break; } } } } while (0)

struct XcdBarrier {
    unsigned* bar; unsigned x;
    volatile LAS unsigned* st;
};

__device__ __forceinline__ XcdBarrier xcd_barrier_post(unsigned* bar, volatile LAS unsigned* st) {
    XcdBarrier b; b.bar = bar; b.x = xb_xcc_id(); b.st = st;
    if (threadIdx.x == 0) (void)xb_add(&bar[XB_XCNT(b.x)], 1u);
    return b;
}
__device__ __forceinline__ void xcd_barrier_complete(unsigned* bar, unsigned x, unsigned& nloc, unsigned& nx) {
    const unsigned G = gridDim.x * gridDim.y * gridDim.z;
    unsigned sum, cnt, mine, sp = 0u;
    for (;;) {
        sum = 0u; cnt = 0u; mine = 0u;
#pragma unroll
        for (unsigned j = 0; j < 16; ++j) { const unsigned c = xb_ld(&bar[XB_XCNT(j)]); sum += c; cnt += (c > 0u) ? 1u : 0u; mine = (j == x) ? c : mine; }
        if (sum == G) break;
        __builtin_amdgcn_s_sleep(1);
        if ((++sp & 255u) == 0u) { if (xb_ld(&bar[XB_TMO])) break; if (sp > XB_SPIN_CAP) { atomicAdd(&bar[XB_TMO], 1u); break; } }
    }
    nloc = mine > 0u ? mine : 1u; nx = cnt > 0u ? cnt : 1u;
}

__device__ __forceinline__ void xcd_barrier(const XcdBarrier& b) {
    asm volatile("s_waitcnt vmcnt(0)" ::: "memory");
    __syncthreads();
    if (threadIdx.x == 0) {
        unsigned* bar = b.bar;
        __builtin_amdgcn_s_waitcnt(0);
        unsigned nloc = b.st[0], nx = b.st[1];
        if (nloc == 0u) { xcd_barrier_complete(bar, b.x, nloc, nx); b.st[0] = nloc; b.st[1] = nx; }
        const unsigned old = xb_add(&bar[XB_XSUB(b.x)], 1u);
        const unsigned gen = old / nloc;
        if (old + 1u == (gen + 1u) * nloc) {
            __builtin_amdgcn_fence(__ATOMIC_RELEASE, "agent");
            asm volatile("s_waitcnt vmcnt(0)" ::: "memory");
            const unsigned og = xb_add(&bar[XB_TOP], 1u);
            const unsigned tg = og / nx;
            if (og + 1u == (tg + 1u) * nx) xb_add(&bar[XB_TOPGEN], 1u);
            else XB_SPIN(xb_ld(&bar[XB_TOPGEN]) == tg, bar);
            __builtin_amdgcn_fence(__ATOMIC_ACQUIRE, "agent");
            xb_add(&bar[XB_XGEN(b.x)], 1u);
            asm volatile("s_waitcnt vmcnt(0)" ::: "memory");
        } else {
            XB_SPIN(xb_ld(&bar[XB_XGEN(b.x)]) == gen, bar);
            __builtin_amdgcn_fence(__ATOMIC_ACQUIRE, "agent");
            asm volatile("s_waitcnt vmcnt(0)" ::: "memory");
        }
    }
    __syncthreads();
}

struct TrDesc { const float* W; bf16_t* WT; const float* gk; int K, N, k0, n0, mode, kd; };
__device__ __forceinline__ void tr_load(const TrDesc& d, float (&vv)[32], int lane) {
    int sc = d.n0 + (lane & 31); if (d.mode == 1) sc = vsrc_in(sc);
    const float* src = d.W + (size_t)(d.k0 + (lane >> 5)) * d.N + (sc < 0 ? 0 : sc);
    const size_t step = (size_t)2 * d.N;
#pragma unroll
    for (int i = 0; i < 32; ++i) { const float v = src[i * step]; vv[i] = (sc < 0) ? 0.f : v; }
}
__device__ __forceinline__ void tr_store(const TrDesc& d, const float (&vv)[32], LAS float* scr, int lane) {
#pragma unroll
    for (int i = 0; i < 32; ++i) { const int kk = 2 * i + (lane >> 5); float v = vv[i];
        if (d.mode == 2) v *= d.gk[d.k0 + kk];
        scr[kk * 33 + (lane & 31)] = v; }
    asm volatile("s_waitcnt lgkmcnt(0)" ::: "memory");
    const int c = lane & 7;
#pragma unroll
    for (int j = 0; j < 4; ++j) { const int n = (lane >> 3) + 8 * j; const LAS float* sp = scr + (8 * c) * 33 + n;
        u32x4 o; o.x = pk2(sp[0 * 33], sp[1 * 33]); o.y = pk2(sp[2 * 33], sp[3 * 33]); o.z = pk2(sp[4 * 33], sp[5 * 33]); o.w = pk2(sp[6 * 33], sp[7 * 33]);
        *(u32x4*)(d.WT + (size_t)(d.n0 + n) * d.K + d.kd + d.k0 + 8 * c) = o; }
    asm volatile("s_waitcnt lgkmcnt(0)" ::: "memory");
}

struct Args {
    const float *x, *c; const int* pos; const float *w_ada, *b_ada, *g_pre, *w_in, *g_kv, *w_ukv, *lq1, *lk1, *lq2, *lk2, *g_subln, *w_o_mla, *w_o_diff, *w_out, *g_post;
    float* out; unsigned char* ws;
};

__global__ void __launch_bounds__(512, 2) fwd_kernel(Args A) {
    extern __shared__ __attribute__((aligned(16))) unsigned char lds_raw[];
    LAS unsigned char* lds = (LAS unsigned char*)lds_raw;
    cg::grid_group grid = cg::this_grid();
    if (A.ws == nullptr) grid.sync();
    { volatile LAS unsigned* st0 = (volatile LAS unsigned*)(lds + LDS_MISC + 64); if (threadIdx.x < 2) st0[threadIdx.x] = 0u; }
    __syncthreads();
    const XcdBarrier xbar = xcd_barrier_post((unsigned*)(A.ws + WS_CTL) + CTL_BAR, (volatile LAS unsigned*)(lds + LDS_MISC + 64));
#if PROBE_DUP == 9
#define GRID_SYNC() do { xcd_barrier(xbar); xcd_barrier(xbar); } while (0)
#else
#define GRID_SYNC() xcd_barrier(xbar)
#endif
    const int G = gridDim.x, NGW = G * 8;
#define PHASE_IDS() int tid = threadIdx.x; asm volatile("" : "+v"(tid)); const int lane = tid & 63, wave = __builtin_amdgcn_readfirstlane(tid >> 6), gw = blockIdx.x * 8 + wave; (void)lane; (void)gw
    unsigned char* ws = A.ws;
    float* ctl = (float*)(ws + WS_CTL);
    float* ssqc = ctl + CTL_SSQC; float* ssqy = ctl + CTL_SSQY; float* ada = ctl + CTL_ADA; unsigned* queue = (unsigned*)(ctl + CTL_QUEUE);
    float* ropec = (float*)(ws + WS_ROPE); float* ropes = ropec + MTOK * 32;
    bf16_t *WUKV = (bf16_t*)(ws + WS_WUKV), *WOM = (bf16_t*)(ws + WS_WOM), *WOD = (bf16_t*)(ws + WS_WOD), *WOUT = (bf16_t*)(ws + WS_WOUT), *WIN = (bf16_t*)(ws + WS_WIN);
    bf16_t *H = (bf16_t*)(ws + WS_H), *MG = (bf16_t*)(ws + WS_H);
    bf16_t *QM = (bf16_t*)(ws + WS_QM), *CKV = (bf16_t*)(ws + WS_CKV), *KM = (bf16_t*)(ws + WS_KM), *VM = (bf16_t*)(ws + WS_VM);
    bf16_t *QD = (bf16_t*)(ws + WS_QD), *KD = (bf16_t*)(ws + WS_KD), *VD = (bf16_t*)(ws + WS_VD), *GM = (bf16_t*)(ws + WS_GM), *GD = (bf16_t*)(ws + WS_GD);
    bf16_t *SM = (bf16_t*)(ws + WS_SM), *SD = (bf16_t*)(ws + WS_SD), *OM = (bf16_t*)(ws + WS_OA), *OD = (bf16_t*)(ws + WS_OA);
    bf16_t* Y = (bf16_t*)(ws + WS_Y);

    {
        PHASE_IDS();
#if PROBE_DUP == 0
#define P0SKIP(rep) ((rep) ? PROBE_DRY : 0)
        for (int rep = 0; rep < 2; ++rep) { float* ada_ = rep ? ctl + 65536 : ada;
#else
#define P0SKIP(rep) 0
        { float* ada_ = ada; const int rep = 0; (void)rep;
#endif
        LAS float* scr = (LAS float*)(lds + wave * 8448);
        constexpr int I_IN = 32 * (INWP / 32), I_UKV = 8 * 64, I_OM = 16 * 64, I_OD = 16 * 64, I_OUT = 32 * 64, I_ADA = 96 * 32;
        constexpr int NTR = I_IN + I_UKV + I_OM + I_OD + I_OUT;
        if (!(P0SKIP(rep) & 1))
        for (int r = gw; r < I_ADA; r += NGW) {
            const int cb = r % 96, kc = r / 96, j = cb * 64 + lane, k0 = kc * 64; float a0 = 0.f, a1 = 0.f;
#pragma unroll
            for (int k = 0; k < 64; ++k) { const float w = A.w_ada[(size_t)(k0 + k) * 6144 + j]; a0 += A.c[k0 + k] * w; a1 += A.c[DM + k0 + k] * w; }
            atomicAdd(ada_ + j, a0); atomicAdd(ada_ + 6144 + j, a1);
        }
#define TR_DECODE(d, it_) do { int r_ = (it_); \
            if (r_ < I_IN) { d.W = A.w_in; d.WT = WIN; d.gk = nullptr; d.kd = 0; d.K = DM; d.N = INW; d.mode = 1; d.k0 = 64 * (r_ % 32); d.n0 = 32 * (r_ / 32); } \
            else if ((r_ -= I_IN) < I_UKV) { d.W = A.w_ukv; d.WT = WUKV; d.gk = A.g_kv; d.kd = 0; d.K = 512; d.N = 2048; d.mode = 2; d.k0 = 64 * (r_ % 8); d.n0 = 32 * (r_ / 8); } \
            else if ((r_ -= I_UKV) < I_OM) { d.W = A.w_o_mla; d.WT = WOM; d.gk = nullptr; d.kd = 0; d.K = 2048; d.N = 2048; d.mode = 0; d.k0 = 64 * (r_ % 16); d.n0 = 32 * (r_ / 16); } \
            else if ((r_ -= I_OM) < I_OD) { d.W = A.w_o_diff; d.WT = WOM; d.gk = nullptr; d.kd = 1024; d.K = 2048; d.N = 2048; d.mode = 0; d.k0 = 64 * (r_ % 16); d.n0 = 32 * (r_ / 16); } \
            else { r_ -= I_OD; d.W = A.w_out; d.WT = WOUT; d.gk = nullptr; d.kd = 0; d.K = 2048; d.N = 2048; d.mode = 0; d.k0 = 64 * (r_ % 32); d.n0 = 32 * (r_ / 32); } } while (0)
        if (!(P0SKIP(rep) & 2)) {
            float va[32], vb[32]; TrDesc da, db; int it = gw;
            if (it < NTR) { TR_DECODE(da, it); tr_load(da, va, lane); }
            while (it < NTR) {
                const int i1 = it + NGW, i2 = it + 2 * NGW;
                if (i1 < NTR) { TR_DECODE(db, i1); tr_load(db, vb, lane); }
                tr_store(da, va, scr, lane);
                if (i1 >= NTR) break;
                if (i2 < NTR) { TR_DECODE(da, i2); tr_load(da, va, lane); }
                tr_store(db, vb, scr, lane);
                it = i2;
            }
        }
#undef TR_DECODE
        if (!(P0SKIP(rep) & 4)) {
            LAS float* invt = (LAS float*)(lds + 8 * 8448);
            __syncthreads();
            if (tid < 32) invt[tid] = powf(10000.0f, -(float)tid / 32.0f);
            __syncthreads();
            for (int e = blockIdx.x * 512 + tid; e < MTOK * 32; e += G * 512) {
                const int t = e >> 5, i = e & 31;
                const float ang = (float)A.pos[t] * invt[i];
                const float k = rintf(ang * 0.6366197723675814f);
                float r = fmaf(-k, 1.5703125f, ang); r = fmaf(-k, 4.837512969970703125e-4f, r); r = fmaf(-k, 7.54978995489188216e-8f, r);
                const float r2 = r * r;
                const float sn = r + r * r2 * (-1.6666667163e-1f + r2 * (8.3333337680e-3f + r2 * (-1.9841270114e-4f + r2 * 2.7557314297e-6f)));
                const float cs = 1.0f + r2 * (-0.5f + r2 * (4.1666667908e-2f + r2 * (-1.3888889225e-3f + r2 * (2.4801587642e-5f + r2 * -2.7557314297e-7f))));
                const int qd = ((int)k) & 3;
                const float s_ = (qd == 0) ? sn : (qd == 1) ? cs : (qd == 2) ? -sn : -cs;
                const float c_ = (qd == 0) ? cs : (qd == 1) ? -sn : (qd == 2) ? -cs : sn;
                ropec[e] = c_; ropes[e] = s_;
            }
        }
        }
    }
    GRID_SYNC();

    {
        PHASE_IDS();
        LAS float* mA = (LAS float*)lds;
        LAS float* mB = mA + 2 * DM;
        for (int e = tid; e < 2 * DM; e += 512) { const int b = e >> 11, n = e & 2047;
            mA[e] = A.g_pre[n] * (1.0f + ada[b * 6144 + 2048 + n] + A.b_ada[2048 + n]); mB[e] = ada[b * 6144 + n] + A.b_ada[n]; }
        __syncthreads();
        for (int m = gw; m < MTOK; m += NGW) {
            const int b = m >> 12; const f32x4* xr = (const f32x4*)(A.x + (size_t)m * DM) + lane;
            f32x4 v[8]; float s = 0.f;
#pragma unroll
            for (int j = 0; j < 8; ++j) { v[j] = xr[64 * j]; s += (v[j][0] * v[j][0] + v[j][1] * v[j][1]) + (v[j][2] * v[j][2] + v[j][3] * v[j][3]); }
            const float rstd = rsqrtf(wave_sum(s) * (1.0f / DM) + EPS);
            u32x2* o8 = (u32x2*)(H + (size_t)m * DM) + lane;
#pragma unroll
            for (int j = 0; j < 8; ++j) { const int n = b * DM + 256 * j + 4 * lane; const f32x4 a = *(const LAS f32x4*)(mA + n), sh = *(const LAS f32x4*)(mB + n);
                u32x2 w; w.x = pk2(v[j][0] * rstd * a[0] + sh[0], v[j][1] * rstd * a[1] + sh[1]); w.y = pk2(v[j][2] * rstd * a[2] + sh[2], v[j][3] * rstd * a[3] + sh[3]);
                o8[64 * j] = w; }
        }
        __syncthreads();
    }
    GRID_SYNC();

#ifndef SKIP_P2
    {
        pg8::Gemm g{H, WIN, MTOK, INWP, DM}; pg8::StaticOrder S; S.init(MTOK, INWP, G, (int)blockIdx.x);
        epi::EpiProj E{QM, CKV, QD, KD, VD, GM, GD, SM, SD, KM, ssqc, ropec, ropes};
        pg8::gemm_phase<epi::EpiProj, pg8::StaticOrder, true, true>(lds, g, S, E);
#if PROBE_DUP == 2
        __syncthreads();
        epi::EpiProj E2{QM, CKV, QD, KD, VD, GM, GD, SM, SD, KM, ctl + 65536, ropec, ropes};
        pg8::gemm_phase<epi::EpiProj, pg8::StaticOrder, true, true>(lds, g, S, E2);
#endif
    }
#endif
    GRID_SYNC();

    {
        pg8::Gemm g{CKV, WUKV, MTOK, 2048, 512}; pg8::StaticOrder S; S.init(MTOK, 2048, G, (int)blockIdx.x);
        epi::EpiUp E{KM, VM, ssqc};
        pg8::gemm_phase<epi::EpiUp, pg8::StaticOrder, true, true>(lds, g, S, E);
    }
    GRID_SYNC();

#ifndef SKIP_P4
    {
        PHASE_IDS();
        att::Ptrs P; P.QM = QM; P.KM = KM; P.VM = VM; P.QD = QD; P.KD = KD; P.VD = VD; P.GM = GM; P.GD = GD; P.OM = OM; P.OD = OD; P.pos = A.pos; P.gsub = A.g_subln;
        { const float s1 = wave_sum(A.lq1[lane] * A.lk1[lane]), s2 = wave_sum(A.lq2[lane] * A.lk2[lane]); P.lam = expf(s1) - expf(s2) + LAMBDA_INIT; }
        LAS unsigned* qslot = (LAS unsigned*)(lds + LDS_MISC);
#if PROBE_DUP == 4
        for (int rep = 0; rep < 2; ++rep)
#else
        const int rep = 0;
#endif
        if (STATIC_PLAN && G == 256) {
            const int x = blockIdx.x & 7, k = blockIdx.x >> 3;
            if (k < 16) { const int bh = 2 * x + (k >> 3), i = k & 7;
                att::attn_unit<true>(lds, bh >> 3, bh & 7, 15 - i, P, rep ? PROBE_DRY : 0);
                att::attn_unit<true>(lds, bh >> 3, bh & 7, i, P, rep ? PROBE_DRY : 0);
            } else { const int j = k - 16;
#pragma unroll 1
                for (int u = 0; u < 4; ++u) { const int bh = 2 * x + (u & 1), qb = (u < 2) ? 31 - j : j;
                    att::attn_unit<false>(lds, bh >> 3, bh & 7, qb, P, rep ? PROBE_DRY : 0); }
            }
        } else
        for (;;) {
            __syncthreads();
            if (tid == 0) *qslot = atomicAdd(queue + rep, 1u);
            __syncthreads();
            int rem = (int)*qslot;
            if (rem >= 768) break;
            int type = -1, qb = 0;
            for (int cv = 160; cv >= 3; --cv) {
                if (cv % 10 == 0) { if (rem < 16) { type = 0; qb = cv / 10 - 1; break; } rem -= 16; }
                if (cv % 3 == 0 && cv <= 96) { if (rem < 16) { type = 1; qb = cv / 3 - 1; break; } rem -= 16; }
            }
            const int b = rem >> 3, h = rem & 7;
            if (type == 0) att::attn_unit<true>(lds, b, h, qb, P, rep ? PROBE_DRY : 0);
            else att::attn_unit<false>(lds, b, h, qb, P, rep ? PROBE_DRY : 0);
        }
        __syncthreads();
    }
#endif
    GRID_SYNC();

    {
        pg8::StaticOrder S; S.init(MTOK, DM, G, (int)blockIdx.x);
        pg8::Gemm g{OM, WOM, MTOK, DM, 2048}; epi::EpiMerge E{SD, MG}; epi::HookMerge Hk{SM, SD};
        pg8::gemm_phase<epi::EpiMerge, pg8::StaticOrder, true, true, epi::HookMerge>(lds, g, S, E, Hk);
    }
    GRID_SYNC();

    {
        pg8::Gemm g{MG, WOUT, MTOK, DM, DM}; pg8::StaticOrder S; S.init(MTOK, DM, G, (int)blockIdx.x);
        epi::EpiOut E{Y, ssqy};
        pg8::gemm_phase<epi::EpiOut, pg8::StaticOrder, true, true>(lds, g, S, E);
    }
    GRID_SYNC();

    {
        PHASE_IDS();
        LAS float* gg = (LAS float*)lds;
        for (int e = tid; e < 2 * DM; e += 512) { const int b = e >> 11, n = e & 2047; gg[e] = (ada[b * 6144 + 4096 + n] + A.b_ada[4096 + n]) * A.g_post[n]; }
        __syncthreads();
        for (int m = gw; m < MTOK; m += NGW) {
            const int b = m >> 12; const float rstd = rsqrtf(ssqy[m] * (1.0f / DM) + EPS);
            const f32x4* xr = (const f32x4*)(A.x + (size_t)m * DM) + lane; const u32x2* yr = (const u32x2*)(Y + (size_t)m * DM) + lane; f32x4* orow = (f32x4*)(A.out + (size_t)m * DM) + lane;
#pragma unroll
            for (int j = 0; j < 8; ++j) { const f32x4 g4 = *(const LAS f32x4*)(gg + b * DM + 256 * j + 4 * lane); const u32x2 yy = yr[64 * j]; const f32x4 y4 = {bflo(yy.x), bfhi(yy.x), bflo(yy.y), bfhi(yy.y)};
                orow[64 * j] = xr[64 * j] + y4 * g4 * rstd; }
        }
    }
}

extern "C" void kernel_launch(void* const* d_in, const int* in_sizes, int n_in, void* d_out, int out_size, void* d_ws, size_t ws_size, hipStream_t stream) {
    static int grid_blocks = 0;
    if (grid_blocks == 0) {
        if (n_in != 18 || in_sizes[0] != MTOK * DM || out_size != MTOK * DM || ws_size < WS_END) { fprintf(stderr, "kernel_launch: unexpected shapes (n_in %d, in0 %d, out %d, ws %zu)\n", n_in, n_in > 0 ? in_sizes[0] : -1, out_size, ws_size); grid_blocks = -1; return; }
        int dev = 0, cus = 0, per_cu = 0;
        (void)hipGetDevice(&dev); (void)hipDeviceGetAttribute(&cus, hipDeviceAttributeMultiprocessorCount, dev);
        if (hipFuncSetAttribute((const void*)fwd_kernel, hipFuncAttributeMaxDynamicSharedMemorySize, LDS_BYTES) != hipSuccess) { fprintf(stderr, "kernel_launch: hipFuncSetAttribute failed\n"); grid_blocks = -1; return; }
        if (hipOccupancyMaxActiveBlocksPerMultiprocessor(&per_cu, (const void*)fwd_kernel, 512, LDS_BYTES) != hipSuccess || per_cu < 1) { fprintf(stderr, "kernel_launch: occupancy query says %d\n", per_cu); per_cu = 1; }
        (void)hipGetLastError();
        grid_blocks = cus;
    }
    if (grid_blocks < 0) return;
    (void)hipMemsetAsync((char*)d_ws + WS_CTL, 0, CTL_BYTES, stream);
    Args a{};
    a.x = (const float*)d_in[0]; a.c = (const float*)d_in[1]; a.pos = (const int*)d_in[2]; a.w_ada = (const float*)d_in[3]; a.b_ada = (const float*)d_in[4]; a.g_pre = (const float*)d_in[5];
    a.w_in = (const float*)d_in[6]; a.g_kv = (const float*)d_in[7]; a.w_ukv = (const float*)d_in[8]; a.lq1 = (const float*)d_in[9]; a.lk1 = (const float*)d_in[10]; a.lq2 = (const float*)d_in[11]; a.lk2 = (const float*)d_in[12];
    a.g_subln = (const float*)d_in[13]; a.w_o_mla = (const float*)d_in[14]; a.w_o_diff = (const float*)d_in[15]; a.w_out = (const float*)d_in[16]; a.g_post = (const float*)d_in[17];
    a.out = (float*)d_out; a.ws = (unsigned char*)d_ws;
    void* args[] = {&a};
    hipError_t e = hipLaunchCooperativeKernel((const void*)fwd_kernel, dim3(grid_blocks), dim3(512), args, LDS_BYTES, stream);
    if (e != hipSuccess) fprintf(stderr, "cooperative launch failed: %s (grid %d)\n", hipGetErrorString(e), grid_blocks);
}
```

```cpp
#include <hip/hip_runtime.h>
#include <hip/hip_cooperative_groups.h>
#include <cstdio>
#include <cstdint>
namespace pg8 {
#define PG8_LAS __attribute__((address_space(3)))
typedef unsigned short bf16_t;
typedef short bf16x8 __attribute__((ext_vector_type(8)));
typedef float f32x4 __attribute__((ext_vector_type(4)));
typedef unsigned u32x4 __attribute__((ext_vector_type(4)));
constexpr int BM = 256, BK = 64, HALF = 128, HTB = HALF * BK * 2  , STAGE_BYTES = 8 * HTB, NXCD = 8, WGM = 8;

__host__ __device__ __forceinline__ int lds_byte(int r, int c) { const int st = (r >> 4) * 2 + (c >> 5), rr = r & 15, cc = c & 31, ob = rr * 64 + cc * 2; return st * 1024 + (ob ^ (((ob >> 9) & 1) << 5)); }
__host__ __device__ __forceinline__ void stage_rc(int b, int& R, int& C) { const int st = b / 1024, sb = b % 1024, swz = sb ^ (((sb >> 9) & 1) << 5); R = (st >> 1) * 16 + swz / 64; C = (st & 1) * 32 + (swz % 64) / 2; }
__host__ __device__ __forceinline__ int perm32(int rho) { const int n = rho >> 4, i = rho & 15; return 8 * (i >> 2) + 4 * n + (i & 3); }

struct Unit { int pm, pn; };
struct Gemm { const bf16_t* A; const bf16_t* Bt; int M, N, K; };

struct StaticOrder {
    int nM, nN, nwg, G, c;
    __host__ __device__ void init(int M, int N, int G_, int c_) { nM = M / BM; nN = N / BM; nwg = nM * nN; G = G_; c = c_; }
    __host__ __device__ bool next(int i, Unit& u) const {
        const long L = (long)i * G + c; if (L >= nwg) return false;
        int wgid = (int)L; { const int q = nwg / NXCD, r = nwg % NXCD, xcd = wgid % NXCD, off = wgid / NXCD; wgid = (xcd < r ? xcd * (q + 1) : r * (q + 1) + (xcd - r) * q) + off; }
        const int nig = WGM * nN, gid = wgid / nig, fm = gid * WGM, gsz = (nM - fm) < WGM ? (nM - fm) : WGM;
        u.pm = fm + ((wgid % nig) % gsz); u.pn = (wgid % nig) / gsz; return true;
    }
    __device__ __forceinline__ void a_ready(const Unit&) const {}
    __device__ __forceinline__ void done(const Unit&) const {}
};

__device__ __forceinline__ unsigned cvt_pk_bf16(float lo, float hi) { unsigned r; asm volatile("v_cvt_pk_bf16_f32 %0, %1, %2" : "=v"(r) : "v"(lo), "v"(hi)); return r; }
struct NoHook { static constexpr bool ON = false; static constexpr int T = 0; template <class A_> __device__ __forceinline__ void mid(A_&, const Unit&, int, int, int, int) const {} };
template <class Epi, class Sched, bool ALIGN_EPI = false, bool SP2 = false, class Hook = NoHook>
__device__ __forceinline__ void gemm_phase(PG8_LAS unsigned char* lds, const Gemm g, const Sched& S, const Epi& E, const Hook& H = Hook()) {
    int tid_ = threadIdx.x; asm volatile("" : "+v"(tid_));
    const int tid = tid_, wid = __builtin_amdgcn_readfirstlane(tid >> 6), lane = tid & 63, wr = wid >> 2, wc = wid & 3, fr = lane & 15, fq = lane >> 4;
    const int K = g.K, nt = K / BK;
    unsigned voffA[2], voffB[2];
#pragma unroll
    for (int i = 0; i < 2; ++i) { int R, C; stage_rc(tid * 16 + i * 8192, R, C); const int Rb = Epi::PERM ? ((R & ~31) + perm32(R & 31)) : R;
        voffA[i] = (unsigned)(R * K + C) * 2u; voffB[i] = (unsigned)(Rb * K + C) * 2u; }
    const size_t kstep = (size_t)(BK * 2);
    const size_t hstep = (size_t)HALF * K * 2;
    const size_t tstep = 2 * hstep;
    const unsigned ldsw = (unsigned)wid * 1024u;
    const int aoff = lds_byte(wr * 64 + fr, fq * 8), boff = lds_byte(wc * 32 + fr, fq * 8);
#define PG8_SA(b, h) (((b) * 2 + (h)) * HTB)
#define PG8_SB(b, h) ((4 + (b) * 2 + (h)) * HTB)
#define PG8_STAGE(bufoff, gbase, voff) do { _Pragma("unroll") for (int _i = 0; _i < 2; ++_i) \
        __builtin_amdgcn_global_load_lds((const unsigned*)((const char*)(gbase) + (voff)[_i]), (PG8_LAS unsigned*)(lds + (bufoff) + ldsw + _i * 8192), 16, 0, 0); } while (0)
#define PG8_LDA(dst, b, h) do { _Pragma("unroll") for (int m = 0; m < 4; ++m) _Pragma("unroll") for (int k = 0; k < 2; ++k) dst[m][k] = *(const PG8_LAS bf16x8*)(lds + PG8_SA(b, h) + aoff + m * 2048 + k * 1024); } while (0)
#define PG8_LDB(dst, b, h) do { _Pragma("unroll") for (int n = 0; n < 2; ++n) _Pragma("unroll") for (int k = 0; k < 2; ++k) dst[n][k] = *(const PG8_LAS bf16x8*)(lds + PG8_SB(b, h) + boff + n * 2048 + k * 1024); } while (0)
#define PG8_MMA(ai, bj, At, Bt) do { __builtin_amdgcn_s_setprio(1); _Pragma("unroll") for (int m = 0; m < 4; ++m) _Pragma("unroll") for (int n = 0; n < 2; ++n) _Pragma("unroll") for (int k = 0; k < 2; ++k) \
        acc[ai][bj][m][n] = __builtin_amdgcn_mfma_f32_16x16x32_bf16(Bt[n][k], At[m][k], acc[ai][bj][m][n], 0, 0, 0); __builtin_amdgcn_s_setprio(0); } while (0)
#define PG8_WAIT_V(n) asm volatile("s_waitcnt vmcnt(" #n ")" ::: "memory")
#define PG8_WAIT_L(n) asm volatile("s_waitcnt lgkmcnt(" #n ")" ::: "memory")
#define PG8_BAR __builtin_amdgcn_s_barrier()
#define PG8_SCHED __builtin_amdgcn_sched_barrier(0)
    Unit cur, nxt; int ui = 0;
    if (!S.next(0, cur)) return;
    f32x4 acc[2][2][4][2];
#pragma unroll
    for (int a = 0; a < 2; ++a)
#pragma unroll
        for (int b = 0; b < 2; ++b)
#pragma unroll
            for (int m = 0; m < 4; ++m)
#pragma unroll
                for (int n = 0; n < 2; ++n) acc[a][b][m][n] = (f32x4){0.f, 0.f, 0.f, 0.f};
    bf16x8 At[4][2], B0[2][2], B1[2][2];
    const char* cA = (const char*)g.A + (size_t)cur.pm * tstep; const char* cB = (const char*)g.Bt + (size_t)cur.pn * tstep;
    S.a_ready(cur);
    if constexpr (SP2) {
        PG8_STAGE(PG8_SB(0, 0), cB, voffB); PG8_STAGE(PG8_SB(0, 1), cB + hstep, voffB); PG8_STAGE(PG8_SA(0, 0), cA, voffA); PG8_STAGE(PG8_SA(0, 1), cA + hstep, voffA);
        if (wr == 1) PG8_BAR;
        PG8_WAIT_V(2); PG8_BAR;
        PG8_STAGE(PG8_SB(1, 0), cB + kstep, voffB); PG8_STAGE(PG8_SA(1, 0), cA + kstep, voffA); PG8_STAGE(PG8_SB(1, 1), cB + hstep + kstep, voffB);
        PG8_WAIT_V(6); PG8_BAR;
    } else {
        PG8_STAGE(PG8_SB(0, 0), cB, voffB); PG8_STAGE(PG8_SA(0, 0), cA, voffA); PG8_STAGE(PG8_SB(0, 1), cB + hstep, voffB); PG8_STAGE(PG8_SA(0, 1), cA + hstep, voffA);
        if (wr == 1) PG8_BAR;
        PG8_WAIT_V(4); PG8_BAR;
        PG8_STAGE(PG8_SB(1, 0), cB + kstep, voffB); PG8_STAGE(PG8_SA(1, 0), cA + kstep, voffA); PG8_STAGE(PG8_SB(1, 1), cB + hstep + kstep, voffB);
        PG8_WAIT_V(6); PG8_BAR;
    }
    for (;;) {
        const bool has_next = S.next(ui + 1, nxt);
        const char* nA = has_next ? (const char*)g.A + (size_t)nxt.pm * tstep : cA; const char* nB = has_next ? (const char*)g.Bt + (size_t)nxt.pn * tstep : cB;
        for (int t = 0; t < nt; t += 2) {
            const bool last = (t == nt - 2);
            const char* a1 = cA + (size_t)(t + 1) * kstep;
            const char* a2 = last ? nA : cA + (size_t)(t + 2) * kstep; const char* b2 = last ? nB : cB + (size_t)(t + 2) * kstep;
            const char* a3 = a2 + kstep; const char* b3 = b2 + kstep;
            if (last && has_next) S.a_ready(nxt);
            if constexpr (Hook::ON) { if (t == Hook::T) H.mid(acc, cur, wr, wc, fr, fq); }
            if constexpr (SP2) {
            PG8_LDB(B0, 0, 0); PG8_LDB(B1, 0, 1); PG8_SCHED; PG8_LDA(At, 0, 0); PG8_STAGE(PG8_SA(1, 1), a1 + hstep, voffA);
            PG8_WAIT_V(8); PG8_WAIT_L(0); PG8_BAR; PG8_MMA(0, 0, At, B0); PG8_MMA(0, 1, At, B1); PG8_BAR; PG8_SCHED;
            PG8_LDA(At, 0, 1); PG8_STAGE(PG8_SB(0, 0), b2, voffB); PG8_STAGE(PG8_SB(0, 1), b2 + hstep, voffB); PG8_STAGE(PG8_SA(0, 0), a2, voffA);
            PG8_WAIT_V(8); PG8_WAIT_L(0); PG8_BAR; PG8_MMA(1, 0, At, B0); PG8_MMA(1, 1, At, B1); PG8_BAR; PG8_SCHED;
            PG8_LDB(B0, 1, 0); PG8_LDB(B1, 1, 1); PG8_SCHED; PG8_LDA(At, 1, 0); PG8_STAGE(PG8_SA(0, 1), a2 + hstep, voffA);
            PG8_WAIT_V(8); PG8_WAIT_L(0); PG8_BAR; PG8_MMA(0, 0, At, B0); PG8_MMA(0, 1, At, B1); PG8_BAR; PG8_SCHED;
            PG8_LDA(At, 1, 1); PG8_STAGE(PG8_SB(1, 0), b3, voffB); PG8_STAGE(PG8_SB(1, 1), b3 + hstep, voffB); PG8_STAGE(PG8_SA(1, 0), a3, voffA);
            PG8_WAIT_V(8); PG8_WAIT_L(0); PG8_BAR; PG8_MMA(1, 0, At, B0); PG8_MMA(1, 1, At, B1); PG8_BAR; PG8_SCHED;
            } else {
            PG8_LDB(B0, 0, 0); PG8_SCHED; PG8_LDA(At, 0, 0); PG8_STAGE(PG8_SA(1, 1), a1 + hstep, voffA);
            PG8_WAIT_L(8); PG8_BAR; PG8_WAIT_L(0); PG8_MMA(0, 0, At, B0); PG8_BAR; PG8_SCHED;
            PG8_LDB(B1, 0, 1); PG8_STAGE(PG8_SB(0, 0), b2, voffB);
            PG8_BAR; PG8_WAIT_L(0); PG8_MMA(0, 1, At, B1); PG8_BAR;
            PG8_LDA(At, 0, 1); PG8_STAGE(PG8_SA(0, 0), a2, voffA);
            PG8_BAR; PG8_WAIT_L(0); PG8_MMA(1, 0, At, B0); PG8_BAR; PG8_SCHED;
            PG8_STAGE(PG8_SB(0, 1), b2 + hstep, voffB);
            PG8_WAIT_V(6); PG8_BAR; PG8_MMA(1, 1, At, B1); PG8_BAR;
            PG8_LDB(B0, 1, 0); PG8_SCHED; PG8_LDA(At, 1, 0); PG8_STAGE(PG8_SA(0, 1), a2 + hstep, voffA);
            PG8_WAIT_L(8); PG8_BAR; PG8_WAIT_L(0); PG8_MMA(0, 0, At, B0); PG8_BAR; PG8_SCHED;
            PG8_LDB(B1, 1, 1); PG8_STAGE(PG8_SB(1, 0), b3, voffB);
            PG8_BAR; PG8_WAIT_L(0); PG8_MMA(0, 1, At, B1); PG8_BAR;
            PG8_LDA(At, 1, 1); PG8_STAGE(PG8_SA(1, 0), a3, voffA);
            PG8_BAR; PG8_WAIT_L(0); PG8_MMA(1, 0, At, B0); PG8_BAR; PG8_SCHED;
            PG8_STAGE(PG8_SB(1, 1), b3 + hstep, voffB);
            PG8_WAIT_V(6); PG8_BAR; PG8_MMA(1, 1, At, B1); PG8_BAR;
            }
        }
        if constexpr (ALIGN_EPI) { if (wr == 0) PG8_BAR; }
        if constexpr (!Epi::AFTER_DRAIN) { E(acc, cur, wr, wc, fr, fq); S.done(cur); }
        if (!has_next) break;
#pragma unroll
        for (int a = 0; a < 2; ++a)
#pragma unroll
            for (int b = 0; b < 2; ++b)
#pragma unroll
                for (int m = 0; m < 4; ++m)
#pragma unroll
                    for (int n = 0; n < 2; ++n) acc[a][b][m][n] = (f32x4){0.f, 0.f, 0.f, 0.f};
        cur = nxt; cA = nA; cB = nB; ++ui;
        if constexpr (ALIGN_EPI) { if (wr == 1) PG8_BAR; }
    }
    PG8_WAIT_V(0);
    if constexpr (!ALIGN_EPI) { if (wr == 0) PG8_BAR; }
    PG8_BAR;
    if constexpr (Epi::AFTER_DRAIN) { E.fused(acc, cur, wr, wc, fr, fq, lds, wid, lane); S.done(cur); }
#undef PG8_SA
#undef PG8_SB
#undef PG8_STAGE
#undef PG8_LDA
#undef PG8_LDB
#undef PG8_MMA
#undef PG8_WAIT_V
#undef PG8_WAIT_L
#undef PG8_BAR
#undef PG8_SCHED
}
}

namespace cg = cooperative_groups;
#ifndef PROBE_DUP
#define PROBE_DUP -1
#endif
#ifndef PROBE_DRY
#define PROBE_DRY 0
#endif
#ifndef STATIC_PLAN
#define STATIC_PLAN 0
#endif
#define LAS __attribute__((address_space(3)))
typedef unsigned short bf16_t;
typedef short bf16x8 __attribute__((ext_vector_type(8)));
typedef short s16x4 __attribute__((ext_vector_type(4)));
typedef float f32x4 __attribute__((ext_vector_type(4)));
typedef float f32x16 __attribute__((ext_vector_type(16)));
typedef unsigned u32x4 __attribute__((ext_vector_type(4)));
typedef unsigned u32x2 __attribute__((ext_vector_type(2)));

constexpr int DM = 2048, NB = 2, SEQ = 4096, MTOK = NB * SEQ;
constexpr int INW = 11328, INWP = 11520;
constexpr float EPS = 1e-6f;
constexpr float LOG2E = 1.4426950408889634f;
constexpr float QS_MLA = 0.07216878364870322f * LOG2E;
constexpr float QS_DIF = 0.125f * LOG2E;
constexpr float LAMBDA_INIT = 0.2f;

constexpr size_t MiB = 1u << 20;
constexpr size_t WS_CTL = 0;
constexpr size_t CTL_BYTES = 1 * MiB;
constexpr size_t WS_ROPE = 2 * MiB;
constexpr size_t WS_WUKV = 4 * MiB, WS_WOM = 6 * MiB, WS_WOD = 10 * MiB, WS_WOUT = 14 * MiB, WS_WIN = 22 * MiB;
constexpr size_t WS_H = 67 * MiB;
constexpr size_t WS_QM = 99 * MiB, WS_CKV = 123 * MiB, WS_KM = 131 * MiB, WS_VM = 155 * MiB;
constexpr size_t WS_QD = 171 * MiB, WS_KD = 187 * MiB, WS_VD = 203 * MiB, WS_GM = 219 * MiB, WS_GD = 235 * MiB;
constexpr size_t WS_SM = 251 * MiB, WS_SD = 283 * MiB, WS_OA = 315 * MiB, WS_END = 347 * MiB;
constexpr size_t WS_Y = 99 * MiB;
constexpr int CTL_BAR = 32768;
constexpr int CTL_SSQC = 0, CTL_SSQY = 8192, CTL_ADA = 16384, CTL_QUEUE = 16384 + 12288;

constexpr int LDS_MAIN = 131072, LDS_MISC = 131072, LDS_BYTES = 135168;

__device__ __forceinline__ unsigned f2bf(float f) { unsigned u = __builtin_bit_cast(unsigned, f); return (u + 0x7fffu + ((u >> 16) & 1u)) >> 16; }
typedef float f32x2_t __attribute__((ext_vector_type(2))); typedef __bf16 bf16x2_t __attribute__((ext_vector_type(2)));
__device__ __forceinline__ unsigned pk2(float lo, float hi) { f32x2_t v = {lo, hi}; bf16x2_t b = __builtin_convertvector(v, bf16x2_t); return __builtin_bit_cast(unsigned, b); }
__device__ __forceinline__ float fexp2(float v) { return __builtin_amdgcn_exp2f(v); }
__device__ __forceinline__ float bf2f(unsigned short b) { return __builtin_bit_cast(float, (unsigned)b << 16); }
__device__ __forceinline__ float bflo(unsigned w) { return __builtin_bit_cast(float, w << 16); }
__device__ __forceinline__ float bfhi(unsigned w) { return __builtin_bit_cast(float, w & 0xffff0000u); }
__device__ __forceinline__ float wave_sum(float v) {
#pragma unroll
    for (int o = 1; o < 64; o <<= 1) v += __shfl_xor(v, o);
    return v;
}
__device__ __forceinline__ float fsigmoid(float v) { return __builtin_amdgcn_rcpf(1.0f + fexp2(-1.4426950408889634f * v)); }

__device__ __forceinline__ int vsrc_in(int v) {
    if (v < 1536) { const int hd = v / 192, w = v - hd * 192; if (w < 128) return v; const int r = w - 128; return hd * 192 + 128 + (r >> 1) + 32 * (r & 1); }
    if (v < 2048) return v;
    if (v < 11264) return v + 64;
    if (v < 11328) { const int r = v - 11264; return 2048 + (r >> 1) + 32 * (r & 1); }
    return -1;
}

namespace epi {
using pg8::Unit;
__device__ __forceinline__ void st8(bf16_t* p, f32x4 a, f32x4 b) {
    u32x4 w; w.x = pk2(a[0], a[1]); w.y = pk2(a[2], a[3]); w.z = pk2(b[0], b[1]); w.w = pk2(b[2], b[3]); *(u32x4*)p = w;
}
__device__ __forceinline__ void rope8(f32x4& v0, f32x4& v1, const float* rc, const float* rs) {
    const f32x4 c4 = *(const f32x4*)rc, s4 = *(const f32x4*)rs;
    f32x4 a, b;
    a[0] = v0[0] * c4[0] - v0[1] * s4[0]; a[1] = v0[1] * c4[0] + v0[0] * s4[0];
    a[2] = v0[2] * c4[1] - v0[3] * s4[1]; a[3] = v0[3] * c4[1] + v0[2] * s4[1];
    b[0] = v1[0] * c4[2] - v1[1] * s4[2]; b[1] = v1[1] * c4[2] + v1[0] * s4[2];
    b[2] = v1[2] * c4[3] - v1[3] * s4[3]; b[3] = v1[3] * c4[3] + v1[2] * s4[3];
    v0 = a; v1 = b;
}
template <int ACT> __device__ __forceinline__ void store_tile(const f32x4 (&acc)[2][2][4][2], bf16_t* dst, int ldc, int colt, int rowb, int colw, float sc) {
#pragma unroll
    for (int ai = 0; ai < 2; ++ai)
#pragma unroll
        for (int m = 0; m < 4; ++m) { bf16_t* rowp = dst + (size_t)(rowb + ai * 128 + m * 16) * ldc + colt + colw;
#pragma unroll
            for (int bj = 0; bj < 2; ++bj) { f32x4 v0 = acc[ai][bj][m][0], v1 = acc[ai][bj][m][1];
                if (ACT == 1) { v0 = v0 * sc; v1 = v1 * sc; }
                if (ACT == 2) {
#pragma unroll
                    for (int i = 0; i < 4; ++i) { v0[i] = v0[i] * fsigmoid(v0[i]); v1[i] = v1[i] * fsigmoid(v1[i]); } }
                if (ACT == 3) {
#pragma unroll
                    for (int i = 0; i < 4; ++i) { v0[i] = fsigmoid(v0[i]); v1[i] = fsigmoid(v1[i]); } }
                st8(rowp + bj * 128, v0, v1); } }
}

struct EpiProj {
    static constexpr bool PERM = true, AFTER_DRAIN = false;
    bf16_t *QM, *CKV, *QD, *KD, *VD, *GM, *GD, *SM, *SD, *KM; float* ssq; const float* rc; const float* rs;
    __device__ __forceinline__ void operator()(const f32x4 (&acc)[2][2][4][2], const Unit& u, int wr, int wc, int fr, int fq) const {
        const int pn = u.pn, rowb = u.pm * 256 + wr * 64 + fr, colw = wc * 32 + 8 * fq;
        if (pn < 6) {
#pragma unroll
            for (int bj = 0; bj < 2; ++bj) { const int col = pn * 256 + bj * 128 + colw, w = col % 192; const bool rp = w >= 128; const int i0 = (w - 128) >> 1;
#pragma unroll
                for (int ai = 0; ai < 2; ++ai)
#pragma unroll
                    for (int m = 0; m < 4; ++m) { const int row = rowb + ai * 128 + m * 16; f32x4 v0 = acc[ai][bj][m][0], v1 = acc[ai][bj][m][1];
                        if (rp) rope8(v0, v1, rc + (size_t)row * 32 + i0, rs + (size_t)row * 32 + i0);
                        v0 = v0 * QS_MLA; v1 = v1 * QS_MLA; st8(QM + (size_t)row * 1536 + col, v0, v1); } }
        } else if (pn < 8) {
            const int colt = (pn - 6) * 256;
#pragma unroll
            for (int ai = 0; ai < 2; ++ai)
#pragma unroll
                for (int m = 0; m < 4; ++m) { const int row = rowb + ai * 128 + m * 16; float s = 0.f;
#pragma unroll
                    for (int bj = 0; bj < 2; ++bj) { const f32x4 v0 = acc[ai][bj][m][0], v1 = acc[ai][bj][m][1];
                        s += (v0[0] * v0[0] + v0[1] * v0[1]) + (v0[2] * v0[2] + v0[3] * v0[3]) + (v1[0] * v1[0] + v1[1] * v1[1]) + (v1[2] * v1[2] + v1[3] * v1[3]);
                        st8(CKV + (size_t)row * 512 + colt + bj * 128 + colw, v0, v1); }
                    s += __shfl_xor(s, 16); s += __shfl_xor(s, 32);
                    if (fq == 0) atomicAdd(ssq + row, s); }
        } else if (pn < 12) store_tile<1>(acc, QD, 1024, (pn - 8) * 256, rowb, colw, QS_DIF);
        else if (pn < 16) store_tile<0>(acc, KD, 1024, (pn - 12) * 256, rowb, colw, 1.f);
        else if (pn < 20) store_tile<0>(acc, VD, 1024, (pn - 16) * 256, rowb, colw, 1.f);
        else if (pn < 24) store_tile<2>(acc, GM, 1024, (pn - 20) * 256, rowb, colw, 1.f);
        else if (pn < 28) store_tile<2>(acc, GD, 1024, (pn - 24) * 256, rowb, colw, 1.f);
        else if (pn < 36) store_tile<3>(acc, SM, 2048, (pn - 28) * 256, rowb, colw, 1.f);
        else if (pn < 44) store_tile<3>(acc, SD, 2048, (pn - 36) * 256, rowb, colw, 1.f);
        else {
            if (wc < 2) { const int i0 = colw >> 1;
#pragma unroll
                for (int ai = 0; ai < 2; ++ai)
#pragma unroll
                    for (int m = 0; m < 4; ++m) { const int row = rowb + ai * 128 + m * 16; f32x4 v0 = acc[ai][0][m][0], v1 = acc[ai][0][m][1];
                        rope8(v0, v1, rc + (size_t)row * 32 + i0, rs + (size_t)row * 32 + i0);
                        const int b = row >> 12, s = row & 4095;
#pragma unroll
                        for (int h = 0; h < 8; ++h) st8(KM + ((size_t)(b * 8 + h) * SEQ + s) * 192 + 128 + colw, v0, v1); } }
        }
    }
};
struct EpiUp {
    static constexpr bool PERM = true, AFTER_DRAIN = false;
    bf16_t *KM, *VM; const float* ssq;
    __device__ __forceinline__ void operator()(const f32x4 (&acc)[2][2][4][2], const Unit& u, int wr, int wc, int fr, int fq) const {
        const int h = u.pn, rowb = u.pm * 256 + wr * 64 + fr, colw = wc * 32 + 8 * fq;
#pragma unroll
        for (int ai = 0; ai < 2; ++ai)
#pragma unroll
            for (int m = 0; m < 4; ++m) { const int row = rowb + ai * 128 + m * 16; const float r = rsqrtf(ssq[row] * (1.0f / 512.0f) + EPS);
                const int b = row >> 12, s = row & 4095;
                st8(KM + ((size_t)(b * 8 + h) * SEQ + s) * 192 + colw, acc[ai][0][m][0] * r, acc[ai][0][m][1] * r);
                st8(VM + (size_t)row * 1024 + h * 128 + colw, acc[ai][1][m][0] * r, acc[ai][1][m][1] * r); }
    }
};
struct EpiO1 {
    static constexpr bool PERM = true, AFTER_DRAIN = false;
    bf16_t* Y; const bf16_t* S;
    __device__ __forceinline__ void operator()(const f32x4 (&acc)[2][2][4][2], const Unit& u, int wr, int wc, int fr, int fq) const {
        const int rowb = u.pm * 256 + wr * 64 + fr, colb = u.pn * 256 + wc * 32 + 8 * fq;
#pragma unroll
        for (int ai = 0; ai < 2; ++ai)
#pragma unroll
            for (int m = 0; m < 4; ++m)
#pragma unroll
                for (int bj = 0; bj < 2; ++bj) { const size_t off = (size_t)(rowb + ai * 128 + m * 16) * DM + colb + bj * 128;
                    const u32x4 g = *(const u32x4*)(S + off); f32x4 v0 = acc[ai][bj][m][0], v1 = acc[ai][bj][m][1];
                    v0[0] *= bflo(g.x); v0[1] *= bfhi(g.x); v0[2] *= bflo(g.y); v0[3] *= bfhi(g.y); v1[0] *= bflo(g.z); v1[1] *= bfhi(g.z); v1[2] *= bflo(g.w); v1[3] *= bfhi(g.w);
                    st8(Y + off, v0, v1); }
    }
};
struct EpiO2 {
    static constexpr bool PERM = true, AFTER_DRAIN = false;
    const bf16_t* Y; const bf16_t* S; bf16_t* MG;
    __device__ __forceinline__ void operator()(const f32x4 (&acc)[2][2][4][2], const Unit& u, int wr, int wc, int fr, int fq) const {
        const int rowb = u.pm * 256 + wr * 64 + fr, colb = u.pn * 256 + wc * 32 + 8 * fq;
#pragma unroll
        for (int ai = 0; ai < 2; ++ai)
#pragma unroll
            for (int m = 0; m < 4; ++m)
#pragma unroll
                for (int bj = 0; bj < 2; ++bj) { const size_t off = (size_t)(rowb + ai * 128 + m * 16) * DM + colb + bj * 128;
                    const u32x4 g = *(const u32x4*)(S + off); f32x4 v0 = acc[ai][bj][m][0], v1 = acc[ai][bj][m][1];
                    const u32x4 yy = *(const u32x4*)(Y + off); const f32x4 y0 = {bflo(yy.x), bfhi(yy.x), bflo(yy.y), bfhi(yy.y)}, y1 = {bflo(yy.z), bfhi(yy.z), bflo(yy.w), bfhi(yy.w)};
                    v0[0] = y0[0] + v0[0] * bflo(g.x); v0[1] = y0[1] + v0[1] * bfhi(g.x); v0[2] = y0[2] + v0[2] * bflo(g.y); v0[3] = y0[3] + v0[3] * bfhi(g.y);
                    v1[0] = y1[0] + v1[0] * bflo(g.z); v1[1] = y1[1] + v1[1] * bfhi(g.z); v1[2] = y1[2] + v1[2] * bflo(g.w); v1[3] = y1[3] + v1[3] * bfhi(g.w);
                    st8(MG + off, v0, v1); }
    }
};
struct HookMerge {
    static constexpr bool ON = true; static constexpr int T = 16;
    const bf16_t *SMp, *SDp;
    __device__ __forceinline__ void mid(f32x4 (&acc)[2][2][4][2], const Unit& u, int wr, int wc, int fr, int fq) const {
        int rowb = u.pm * 256 + wr * 64 + fr, colb = u.pn * 256 + wc * 32 + 8 * fq;
        asm volatile("" : "+v"(rowb), "+v"(colb));
#pragma unroll
        for (int ai = 0; ai < 2; ++ai)
#pragma unroll
            for (int m = 0; m < 4; ++m) {
#pragma unroll
                for (int bj = 0; bj < 2; ++bj) { const size_t off = (size_t)(rowb + ai * 128 + m * 16) * DM + colb + bj * 128;
                    const u32x4 a = *(const u32x4*)(SMp + off), d = *(const u32x4*)(SDp + off);
                    f32x4 r0, r1;
                    r0[0] = bflo(a.x) * __builtin_amdgcn_rcpf(bflo(d.x)); r0[1] = bfhi(a.x) * __builtin_amdgcn_rcpf(bfhi(d.x)); r0[2] = bflo(a.y) * __builtin_amdgcn_rcpf(bflo(d.y)); r0[3] = bfhi(a.y) * __builtin_amdgcn_rcpf(bfhi(d.y));
                    r1[0] = bflo(a.z) * __builtin_amdgcn_rcpf(bflo(d.z)); r1[1] = bfhi(a.z) * __builtin_amdgcn_rcpf(bfhi(d.z)); r1[2] = bflo(a.w) * __builtin_amdgcn_rcpf(bflo(d.w)); r1[3] = bfhi(a.w) * __builtin_amdgcn_rcpf(bfhi(d.w));
                    acc[ai][bj][m][0] = acc[ai][bj][m][0] * r0; acc[ai][bj][m][1] = acc[ai][bj][m][1] * r1; }
                if (m & 1) asm volatile("" ::: "memory");
            }
    }
};
struct EpiMerge {
    static constexpr bool PERM = true, AFTER_DRAIN = false;
    const bf16_t* S; bf16_t* MG;
    __device__ __forceinline__ void operator()(const f32x4 (&acc)[2][2][4][2], const Unit& u, int wr, int wc, int fr, int fq) const {
        const int rowb = u.pm * 256 + wr * 64 + fr, colb = u.pn * 256 + wc * 32 + 8 * fq;
#pragma unroll
        for (int ai = 0; ai < 2; ++ai)
#pragma unroll
            for (int m = 0; m < 4; ++m)
#pragma unroll
                for (int bj = 0; bj < 2; ++bj) { const size_t off = (size_t)(rowb + ai * 128 + m * 16) * DM + colb + bj * 128;
                    const u32x4 g = *(const u32x4*)(S + off); f32x4 v0 = acc[ai][bj][m][0], v1 = acc[ai][bj][m][1];
                    v0[0] *= bflo(g.x); v0[1] *= bfhi(g.x); v0[2] *= bflo(g.y); v0[3] *= bfhi(g.y); v1[0] *= bflo(g.z); v1[1] *= bfhi(g.z); v1[2] *= bflo(g.w); v1[3] *= bfhi(g.w);
                    st8(MG + off, v0, v1); }
    }
};
struct EpiOut {
    static constexpr bool PERM = true, AFTER_DRAIN = false;
    bf16_t* Y; float* ssq;
    __device__ __forceinline__ void operator()(const f32x4 (&acc)[2][2][4][2], const Unit& u, int wr, int wc, int fr, int fq) const {
        const int rowb = u.pm * 256 + wr * 64 + fr, colb = u.pn * 256 + wc * 32 + 8 * fq;
#pragma unroll
        for (int ai = 0; ai < 2; ++ai)
#pragma unroll
            for (int m = 0; m < 4; ++m) { const int row = rowb + ai * 128 + m * 16; float s = 0.f;
#pragma unroll
                for (int bj = 0; bj < 2; ++bj) { const size_t off = (size_t)row * DM + colb + bj * 128; const f32x4 v0 = acc[ai][bj][m][0], v1 = acc[ai][bj][m][1];
                    s += (v0[0] * v0[0] + v0[1] * v0[1]) + (v0[2] * v0[2] + v0[3] * v0[3]) + (v1[0] * v1[0] + v1[1] * v1[1]) + (v1[2] * v1[2] + v1[3] * v1[3]);
                    st8(Y + off, v0, v1); }
                s += __shfl_xor(s, 16); s += __shfl_xor(s, 32);
                if (fq == 0) atomicAdd(ssq + row, s); }
    }
};
}

namespace att {
constexpr int KBUF = 25600, VBUF = 20480, VROW = 320;
constexpr int OFF_K = 0, OFF_V = 2 * KBUF, OFF_POS = OFF_V + 2 * VBUF, OFF_WSF = OFF_POS + 512, OFF_END = OFF_WSF + 8 * 256;
static_assert(OFF_END <= LDS_MAIN, "attention LDS");
constexpr float NEG = -1e30f;
struct Ptrs { const bf16_t *QM, *KM, *VM, *QD, *KD, *VD, *GM, *GD; bf16_t *OM, *OD; const int* pos; const float* gsub; float lam; };
__device__ __forceinline__ int crow(int r, int hi) { return (r & 3) + 8 * (r >> 2) + 4 * hi; }
__device__ __forceinline__ float xmax(float v) { const unsigned u = __float_as_uint(v); auto rr = __builtin_amdgcn_permlane32_swap(u, u, false, false); return fmaxf(__uint_as_float(rr[0]), __uint_as_float(rr[1])); }
__device__ __forceinline__ float xsum(float v) { const unsigned u = __float_as_uint(v); auto rr = __builtin_amdgcn_permlane32_swap(u, u, false, false); return __uint_as_float(rr[0]) + __uint_as_float(rr[1]); }
__device__ __forceinline__ s16x4 vtr(const LAS unsigned char* p) { return __builtin_bit_cast(s16x4, __builtin_amdgcn_ds_read_tr16_b64_v4i16((LAS s16x4*)p)); }
__device__ __forceinline__ bf16x8 pack8(const f32x16& p, int s) {
    u32x4 w; w.x = pk2(p[8 * s + 0], p[8 * s + 1]); w.y = pk2(p[8 * s + 2], p[8 * s + 3]); w.z = pk2(p[8 * s + 4], p[8 * s + 5]); w.w = pk2(p[8 * s + 6], p[8 * s + 7]);
    return __builtin_bit_cast(bf16x8, w);
}

template <bool MLA, bool SAFE> __device__ __forceinline__ int attn_unit(LAS unsigned char* lds, const int b, const int h, const int qb, const Ptrs& P, const int dry) {
    constexpr int ROWS = MLA ? 256 : 128, DK = MLA ? 192 : 64, DKT = MLA ? 192 : 128, KROW = DKT * 2 + 16, CPR = DKT / 8, KCH = (64 * CPR) / 512, ND = DK / 16;
    int tid_ = threadIdx.x; asm volatile("" : "+v"(tid_));
    const int tid = tid_, lane = tid & 63, wid = __builtin_amdgcn_readfirstlane(tid >> 6), r32 = lane & 31, hi = lane >> 5;
    const int rg = MLA ? wid : (wid >> 1), c = MLA ? 0 : (wid & 1);
    const int q0 = qb * ROWS, q0w = q0 + 32 * rg, qabs = q0w + r32;
    const size_t tokb = (size_t)b * SEQ;
    const bf16_t* Kg = MLA ? P.KM + ((size_t)(b * 8 + h) * SEQ) * 192 : P.KD + tokb * 1024 + h * 128;
    constexpr int KLD = MLA ? 192 : 1024;
    const bf16_t* Vg = (MLA ? P.VM : P.VD) + tokb * 1024 + h * 128;
    bf16x8 qf[ND];
    { const bf16_t* Qg = MLA ? P.QM + (tokb + qabs) * 1536 + h * 192 : P.QD + (tokb + qabs) * 1024 + h * 128 + c * 64;
#pragma unroll
      for (int d0 = 0; d0 < ND; ++d0) qf[d0] = *(const bf16x8*)(Qg + d0 * 16 + hi * 8); }
    float posq = 0.f, slope2 = 0.f;
    if (!MLA) { posq = (float)P.pos[tokb + qabs]; slope2 = exp2f(-(float)(h + 1)) * LOG2E; }
#pragma unroll
    for (int d0 = 0; d0 < ND; ++d0) asm volatile("" : "+v"(qf[d0]));
    asm volatile("" : "+v"(posq), "+v"(slope2));
    u32x4 kreg[KCH], vreg[2]; int preg = 0;
    int krow[KCH], kch[KCH], vrow[2], vch[2];
#pragma unroll
    for (int i = 0; i < KCH; ++i) { const int idx = tid + 512 * i; krow[i] = idx / CPR; kch[i] = idx % CPR; }
#pragma unroll
    for (int i = 0; i < 2; ++i) { const int idx = tid + 512 * i; vrow[i] = idx >> 4; vch[i] = idx & 15; }
#define ATT_LOAD(j) do { const int kv0_ = 64 * (j); \
        _Pragma("unroll") for (int i = 0; i < KCH; ++i) kreg[i] = *(const u32x4*)(Kg + (size_t)(kv0_ + krow[i]) * KLD + kch[i] * 8); \
        _Pragma("unroll") for (int i = 0; i < 2; ++i) vreg[i] = *(const u32x4*)(Vg + (size_t)(kv0_ + vrow[i]) * 1024 + vch[i] * 8); \
        if (!MLA) { if (tid < 64) preg = P.pos[tokb + kv0_ + tid]; } } while (0)
#define ATT_WRITE(bf) do { \
        _Pragma("unroll") for (int i = 0; i < KCH; ++i) *(LAS u32x4*)(lds + OFF_K + (bf) * KBUF + krow[i] * KROW + kch[i] * 16) = kreg[i]; \
        _Pragma("unroll") for (int i = 0; i < 2; ++i) *(LAS u32x4*)(lds + OFF_V + (bf) * VBUF + vrow[i] * VROW + vch[i] * 16) = vreg[i]; \
        if (!MLA) { if (tid < 64) *(LAS float*)(lds + OFF_POS + (bf) * 256 + tid * 4) = (float)preg; } } while (0)

    LAS float* wsf = (LAS float*)(lds + OFF_WSF + wid * 256);
    f32x16 o[4];
#pragma unroll
    for (int d = 0; d < 4; ++d)
#pragma unroll
        for (int r = 0; r < 16; ++r) o[d][r] = 0.f;
    float mrun = NEG, lrun = 0.f;
    const int NT = (q0 + ROWS) / 64;
    const int kbase = (r32)*KROW + c * 128 + hi * 16;
    const int vbase = (4 * hi + ((lane & 15) >> 2)) * VROW + (((lane >> 4) & 1) * 16 + (lane & 3) * 4) * 2;

    ATT_LOAD(0);
    __syncthreads();
    ATT_WRITE(0);
    for (int j = 0; j < NT; ++j) {
        const int bf = j & 1;
        if (j + 1 < NT && !(dry & 4)) ATT_LOAD(j + 1);
        __syncthreads();
        const int kv0 = 64 * j;
#pragma unroll 1
        for (int kvh = 0; kvh < 2; ++kvh) {
            const int kvs = kv0 + 32 * kvh;
            if (kvs > q0w + 31 || (dry & 1) || ((dry & 8) && (wid & 4))) break;
            const LAS unsigned char* Kb = lds + OFF_K + bf * KBUF + kbase + kvh * 32 * KROW;
            bf16x8 kf[ND];
#pragma unroll
            for (int d0 = 0; d0 < ND; ++d0) kf[d0] = *(const LAS bf16x8*)(Kb + d0 * 32);
            __builtin_amdgcn_sched_barrier(0);
            f32x16 p;
#pragma unroll
            for (int r = 0; r < 16; ++r) p[r] = 0.f;
#pragma unroll
            for (int d0 = 0; d0 < ND; ++d0) p = __builtin_amdgcn_mfma_f32_32x32x16_bf16(kf[d0], qf[d0], p, 0, 0, 0);
            __builtin_amdgcn_sched_barrier(0);
            const LAS unsigned char* Vb = lds + OFF_V + bf * VBUF + vbase + kvh * 32 * VROW;
            s16x4 vlo[8], vhi[8];
#pragma unroll
            for (int s2 = 0; s2 < 2; ++s2)
#pragma unroll
                for (int db = 0; db < 4; ++db) { vlo[s2 * 4 + db] = vtr(Vb + s2 * 16 * VROW + db * 64); vhi[s2 * 4 + db] = vtr(Vb + s2 * 16 * VROW + 8 * VROW + db * 64); }
            __builtin_amdgcn_sched_barrier(0);
            if (!MLA) {
                const LAS float* pp = (const LAS float*)(lds + OFF_POS + bf * 256) + 32 * kvh + 4 * hi;
#pragma unroll
                for (int g = 0; g < 4; ++g) { const f32x4 a = *(const LAS f32x4*)(pp + 8 * g);
#pragma unroll
                    for (int i = 0; i < 4; ++i) p[4 * g + i] -= slope2 * fabsf(posq - a[i]); }
            }
            if (kvs + 31 > q0w) {
#pragma unroll
                for (int r = 0; r < 16; ++r) { if (kvs + crow(r, hi) > qabs) p[r] = NEG; }
            }
            if (SAFE) {
            float mx;
            { const float m0 = fmaxf(fmaxf(p[0], p[1]), fmaxf(p[2], p[3])), m1 = fmaxf(fmaxf(p[4], p[5]), fmaxf(p[6], p[7]));
              const float m2 = fmaxf(fmaxf(p[8], p[9]), fmaxf(p[10], p[11])), m3 = fmaxf(fmaxf(p[12], p[13]), fmaxf(p[14], p[15]));
              mx = fmaxf(fmaxf(m0, m1), fmaxf(m2, m3)); }
            mx = xmax(mx);
            const float mnew = fmaxf(mrun, mx), alpha = fexp2(mrun - mnew);
            mrun = mnew;
            float rs0 = 0.f, rs1 = 0.f, rs2 = 0.f, rs3 = 0.f;
#pragma unroll
            for (int r = 0; r < 16; r += 4) { p[r] = fexp2(p[r] - mnew); p[r + 1] = fexp2(p[r + 1] - mnew); p[r + 2] = fexp2(p[r + 2] - mnew); p[r + 3] = fexp2(p[r + 3] - mnew);
                rs0 += p[r]; rs1 += p[r + 1]; rs2 += p[r + 2]; rs3 += p[r + 3]; }
            lrun = lrun * alpha + ((rs0 + rs1) + (rs2 + rs3));
            if (__any(alpha != 1.0f)) {
                if (hi == 0) wsf[r32] = alpha;
#pragma unroll
                for (int g = 0; g < 4; ++g) { const f32x4 a4 = *(const LAS f32x4*)(wsf + 8 * g + 4 * hi);
#pragma unroll
                    for (int d = 0; d < 4; ++d)
#pragma unroll
                        for (int i = 0; i < 4; ++i) o[d][4 * g + i] *= a4[i]; }
            }
            } else {
            float rs0 = 0.f, rs1 = 0.f, rs2 = 0.f, rs3 = 0.f;
#pragma unroll
            for (int r = 0; r < 16; r += 4) { p[r] = fexp2(p[r]); p[r + 1] = fexp2(p[r + 1]); p[r + 2] = fexp2(p[r + 2]); p[r + 3] = fexp2(p[r + 3]);
                rs0 += p[r]; rs1 += p[r + 1]; rs2 += p[r + 2]; rs3 += p[r + 3]; }
            lrun += (rs0 + rs1) + (rs2 + rs3);
            }
            __builtin_amdgcn_sched_barrier(0);
#pragma unroll
            for (int s2 = 0; s2 < 2; ++s2) {
                const bf16x8 pa = pack8(p, s2);
#pragma unroll
                for (int db = 0; db < 4; ++db) {
                    const s16x4 lo = vlo[s2 * 4 + db], hh = vhi[s2 * 4 + db];
                    const bf16x8 vb = (bf16x8){lo[0], lo[1], lo[2], lo[3], hh[0], hh[1], hh[2], hh[3]};
                    o[db] = __builtin_amdgcn_mfma_f32_32x32x16_bf16(pa, vb, o[db], 0, 0, 0);
                }
            }
        }
        if (j + 1 < NT && !(dry & 4)) ATT_WRITE(bf ^ 1);
    }
#undef ATT_LOAD
#undef ATT_WRITE
    int q0e = q0w, r32e = r32, hie = hi; asm volatile("" : "+s"(q0e), "+v"(r32e), "+v"(hie));
    if (dry) { if (dry & 1) asm volatile("" :: "v"(qf[0]), "v"(qf[ND - 1])); else asm volatile("" :: "v"(o[0]), "v"(o[1]), "v"(o[2]), "v"(o[3]), "v"(lrun)); return 0; }
    float lt = xsum(lrun);
    const int bad = SAFE ? 0 : (int)__any(!(lt < 1e30f));
    if (hie == 0) wsf[32 + r32e] = 1.0f / lt;
    f32x4 li[4];
#pragma unroll
    for (int g = 0; g < 4; ++g) li[g] = *(const LAS f32x4*)(wsf + 32 + 8 * g + 4 * hie);
    constexpr int SROW = 272;
    if (MLA) {
        __syncthreads();
        LAS unsigned char* stg = lds + wid * (32 * SROW);
#pragma unroll
        for (int r = 0; r < 16; ++r)
#pragma unroll
            for (int db = 0; db < 4; ++db) *(LAS bf16_t*)(stg + crow(r, hie) * SROW + (32 * db + r32e) * 2) = (bf16_t)f2bf(o[db][r] * li[r >> 2][r & 3]);
        asm volatile("s_waitcnt lgkmcnt(0)" ::: "memory");
#pragma unroll
        for (int i = 0; i < 8; ++i) { const int idx = i * 64 + lane, row = idx >> 4, ch = idx & 15;
            const u32x4 ov = *(const LAS u32x4*)(stg + row * SROW + ch * 16);
            const size_t off = (tokb + q0e + row) * 1024 + h * 128 + ch * 8, offo = (tokb + q0e + row) * 2048 + h * 128 + ch * 8;
            const u32x4 g = *(const u32x4*)(P.GM + off);
            u32x4 w; w.x = pk2(bflo(ov.x) * bflo(g.x), bfhi(ov.x) * bfhi(g.x)); w.y = pk2(bflo(ov.y) * bflo(g.y), bfhi(ov.y) * bfhi(g.y));
            w.z = pk2(bflo(ov.z) * bflo(g.z), bfhi(ov.z) * bfhi(g.z)); w.w = pk2(bflo(ov.w) * bflo(g.w), bfhi(ov.w) * bfhi(g.w));
            *(u32x4*)(P.OM + offo) = w; }
    } else {
        LAS float* comb = (LAS float*)lds;
        __syncthreads();
        if (c == 1) {
#pragma unroll
            for (int r = 0; r < 16; ++r)
#pragma unroll
                for (int db = 0; db < 4; ++db) comb[((rg * 16 + r) * 2 + hie) * 128 + db * 32 + r32e] = o[db][r] * li[r >> 2][r & 3];
        }
        __syncthreads();
        if (c == 0) {
            float gs[4];
#pragma unroll
            for (int db = 0; db < 4; ++db) gs[db] = P.gsub[32 * db + r32e] * (1.0f - LAMBDA_INIT);
#pragma unroll
            for (int r = 0; r < 16; ++r)
#pragma unroll
                for (int db = 0; db < 4; ++db) o[db][r] = o[db][r] * li[r >> 2][r & 3] - P.lam * comb[((rg * 16 + r) * 2 + hie) * 128 + db * 32 + r32e];
            asm volatile("s_waitcnt lgkmcnt(0)" ::: "memory");
            LAS unsigned char* stg = lds + rg * 16384;
#pragma unroll
            for (int r = 0; r < 16; ++r) { float ss = 0.f;
#pragma unroll
                for (int db = 0; db < 4; ++db) ss += o[db][r] * o[db][r];
                ss += __shfl_xor(ss, 1); ss += __shfl_xor(ss, 2); ss += __shfl_xor(ss, 4); ss += __shfl_xor(ss, 8); ss += __shfl_xor(ss, 16);
                const float rstd = rsqrtf(ss * (1.0f / 128.0f) + EPS);
#pragma unroll
                for (int db = 0; db < 4; ++db) *(LAS bf16_t*)(stg + crow(r, hie) * SROW + (32 * db + r32e) * 2) = (bf16_t)f2bf(o[db][r] * rstd * gs[db]); }
            asm volatile("s_waitcnt lgkmcnt(0)" ::: "memory");
#pragma unroll
            for (int i = 0; i < 8; ++i) { const int idx = i * 64 + lane, row = idx >> 4, ch = idx & 15;
                const u32x4 ov = *(const LAS u32x4*)(stg + row * SROW + ch * 16);
                const size_t off = (tokb + q0e + row) * 1024 + h * 128 + ch * 8, offo = (tokb + q0e + row) * 2048 + 1024 + h * 128 + ch * 8;
                const u32x4 g = *(const u32x4*)(P.GD + off);
                u32x4 w; w.x = pk2(bflo(ov.x) * bflo(g.x), bfhi(ov.x) * bfhi(g.x)); w.y = pk2(bflo(ov.y) * bflo(g.y), bfhi(ov.y) * bfhi(g.y));
                w.z = pk2(bflo(ov.z) * bflo(g.z), bfhi(ov.z) * bfhi(g.z)); w.w = pk2(bflo(ov.w) * bflo(g.w), bfhi(ov.w) * bfhi(g.w));
                *(u32x4*)(P.OD + offo) = w; }
        }
    }
    return bad;
}
}

#define XB_TMO      128
#define XB_XCNT(j)  (256  + 64 * (j))
#define XB_XSUB(j)  (1280 + 64 * (j))
#define XB_XGEN(j)  (2304 + 64 * (j))
#define XB_TOP      3328
#define XB_TOPGEN   3392
#define XCD_BAR_WORDS 3456
#define XB_SPIN_CAP (1u << 18)

__device__ __forceinline__ unsigned xb_ld(unsigned* p)              { return __hip_atomic_load(p, __ATOMIC_RELAXED, __HIP_MEMORY_SCOPE_AGENT); }
__device__ __forceinline__ unsigned xb_add(unsigned* p, unsigned v) { return __hip_atomic_fetch_add(p, v, __ATOMIC_RELAXED, __HIP_MEMORY_SCOPE_AGENT); }
__device__ __forceinline__ unsigned xb_xcc_id() { return (unsigned)__builtin_amdgcn_s_getreg((3 << 11) | 20) & 0xFu; }
#define XB_SPIN(cond, bar) do { unsigned _sp = 0; while (cond) { __builtin_amdgcn_s_sleep(1); \
    if ((++_sp & 255u) == 0u) { if (xb_ld(&(bar)[XB_TMO])) break; if (_sp > XB_SPIN_CAP) { atomicAdd(&(bar)[XB_TMO], 1u); break; } } } } while (0)

struct XcdBarrier {
    unsigned* bar; unsigned x;
    volatile LAS unsigned* st;
};

__device__ __forceinline__ XcdBarrier xcd_barrier_post(unsigned* bar, volatile LAS unsigned* st) {
    XcdBarrier b; b.bar = bar; b.x = xb_xcc_id(); b.st = st;
    if (threadIdx.x == 0) (void)xb_add(&bar[XB_XCNT(b.x)], 1u);
    return b;
}
__device__ __forceinline__ void xcd_barrier_complete(unsigned* bar, unsigned x, unsigned& nloc, unsigned& nx) {
    const unsigned G = gridDim.x * gridDim.y * gridDim.z;
    unsigned sum, cnt, mine, sp = 0u;
    for (;;) {
        sum = 0u; cnt = 0u; mine = 0u;
#pragma unroll
        for (unsigned j = 0; j < 16; ++j) { const unsigned c = xb_ld(&bar[XB_XCNT(j)]); sum += c; cnt += (c > 0u) ? 1u : 0u; mine = (j == x) ? c : mine; }
        if (sum == G) break;
        __builtin_amdgcn_s_sleep(1);
        if ((++sp & 255u) == 0u) { if (xb_ld(&bar[XB_TMO])) break; if (sp > XB_SPIN_CAP) { atomicAdd(&bar[XB_TMO], 1u); break; } }
    }
    nloc = mine > 0u ? mine : 1u; nx = cnt > 0u ? cnt : 1u;
}

__device__ __forceinline__ void xcd_barrier(const XcdBarrier& b) {
    asm volatile("s_waitcnt vmcnt(0)" ::: "memory");
    __syncthreads();
    if (threadIdx.x == 0) {
        unsigned* bar = b.bar;
        __builtin_amdgcn_s_waitcnt(0);
        unsigned nloc = b.st[0], nx = b.st[1];
        if (nloc == 0u) { xcd_barrier_complete(bar, b.x, nloc, nx); b.st[0] = nloc; b.st[1] = nx; }
        const unsigned old = xb_add(&bar[XB_XSUB(b.x)], 1u);
        const unsigned gen = old / nloc;
        if (old + 1u == (gen + 1u) * nloc) {
            __builtin_amdgcn_fence(__ATOMIC_RELEASE, "agent");
            asm volatile("s_waitcnt vmcnt(0)" ::: "memory");
            const unsigned og = xb_add(&bar[XB_TOP], 1u);
            const unsigned tg = og / nx;
            if (og + 1u == (tg + 1u) * nx) xb_add(&bar[XB_TOPGEN], 1u);
            else XB_SPIN(xb_ld(&bar[XB_TOPGEN]) == tg, bar);
            __builtin_amdgcn_fence(__ATOMIC_ACQUIRE, "agent");
            xb_add(&bar[XB_XGEN(b.x)], 1u);
            asm volatile("s_waitcnt vmcnt(0)" ::: "memory");
        } else {
            XB_SPIN(xb_ld(&bar[XB_XGEN(b.x)]) == gen, bar);
            __builtin_amdgcn_fence(__ATOMIC_ACQUIRE, "agent");
            asm volatile("s_waitcnt vmcnt(0)" ::: "memory");
        }
    }
    __syncthreads();
}

struct TrDesc { const float* W; bf16_t* WT; const float* gk; int K, N, k0, n0, mode, kd; };
__device__ __forceinline__ void tr_load(const TrDesc& d, float (&vv)[32], int lane) {
    int sc = d.n0 + (lane & 31); if (d.mode == 1) sc = vsrc_in(sc);
    const float* src = d.W + (size_t)(d.k0 + (lane >> 5)) * d.N + (sc < 0 ? 0 : sc);
    const size_t step = (size_t)2 * d.N;
#pragma unroll
    for (int i = 0; i < 32; ++i) { const float v = src[i * step]; vv[i] = (sc < 0) ? 0.f : v; }
}
__device__ __forceinline__ void tr_store(const TrDesc& d, const float (&vv)[32], LAS float* scr, int lane) {
#pragma unroll
    for (int i = 0; i < 32; ++i) { const int kk = 2 * i + (lane >> 5); float v = vv[i];
        if (d.mode == 2) v *= d.gk[d.k0 + kk];
        scr[kk * 33 + (lane & 31)] = v; }
    asm volatile("s_waitcnt lgkmcnt(0)" ::: "memory");
    const int c = lane & 7;
#pragma unroll
    for (int j = 0; j < 4; ++j) { const int n = (lane >> 3) + 8 * j; const LAS float* sp = scr + (8 * c) * 33 + n;
        u32x4 o; o.x = pk2(sp[0 * 33], sp[1 * 33]); o.y = pk2(sp[2 * 33], sp[3 * 33]); o.z = pk2(sp[4 * 33], sp[5 * 33]); o.w = pk2(sp[6 * 33], sp[7 * 33]);
        *(u32x4*)(d.WT + (size_t)(d.n0 + n) * d.K + d.kd + d.k0 + 8 * c) = o; }
    asm volatile("s_waitcnt lgkmcnt(0)" ::: "memory");
}

struct Args {
    const float *x, *c; const int* pos; const float *w_ada, *b_ada, *g_pre, *w_in, *g_kv, *w_ukv, *lq1, *lk1, *lq2, *lk2, *g_subln, *w_o_mla, *w_o_diff, *w_out, *g_post;
    float* out; unsigned char* ws;
};

__global__ void __launch_bounds__(512, 2) fwd_kernel(Args A) {
    extern __shared__ __attribute__((aligned(16))) unsigned char lds_raw[];
    LAS unsigned char* lds = (LAS unsigned char*)lds_raw;
    cg::grid_group grid = cg::this_grid();
    if (A.ws == nullptr) grid.sync();
    { volatile LAS unsigned* st0 = (volatile LAS unsigned*)(lds + LDS_MISC + 64); if (threadIdx.x < 2) st0[threadIdx.x] = 0u; }
    __syncthreads();
    const XcdBarrier xbar = xcd_barrier_post((unsigned*)(A.ws + WS_CTL) + CTL_BAR, (volatile LAS unsigned*)(lds + LDS_MISC + 64));
#if PROBE_DUP == 9
#define GRID_SYNC() do { xcd_barrier(xbar); xcd_barrier(xbar); } while (0)
#else
#define GRID_SYNC() xcd_barrier(xbar)
#endif
    const int G = gridDim.x, NGW = G * 8;
#define PHASE_IDS() int tid = threadIdx.x; asm volatile("" : "+v"(tid)); const int lane = tid & 63, wave = __builtin_amdgcn_readfirstlane(tid >> 6), gw = blockIdx.x * 8 + wave; (void)lane; (void)gw
    unsigned char* ws = A.ws;
    float* ctl = (float*)(ws + WS_CTL);
    float* ssqc = ctl + CTL_SSQC; float* ssqy = ctl + CTL_SSQY; float* ada = ctl + CTL_ADA; unsigned* queue = (unsigned*)(ctl + CTL_QUEUE);
    float* ropec = (float*)(ws + WS_ROPE); float* ropes = ropec + MTOK * 32;
    bf16_t *WUKV = (bf16_t*)(ws + WS_WUKV), *WOM = (bf16_t*)(ws + WS_WOM), *WOD = (bf16_t*)(ws + WS_WOD), *WOUT = (bf16_t*)(ws + WS_WOUT), *WIN = (bf16_t*)(ws + WS_WIN);
    bf16_t *H = (bf16_t*)(ws + WS_H), *MG = (bf16_t*)(ws + WS_H);
    bf16_t *QM = (bf16_t*)(ws + WS_QM), *CKV = (bf16_t*)(ws + WS_CKV), *KM = (bf16_t*)(ws + WS_KM), *VM = (bf16_t*)(ws + WS_VM);
    bf16_t *QD = (bf16_t*)(ws + WS_QD), *KD = (bf16_t*)(ws + WS_KD), *VD = (bf16_t*)(ws + WS_VD), *GM = (bf16_t*)(ws + WS_GM), *GD = (bf16_t*)(ws + WS_GD);
    bf16_t *SM = (bf16_t*)(ws + WS_SM), *SD = (bf16_t*)(ws + WS_SD), *OM = (bf16_t*)(ws + WS_OA), *OD = (bf16_t*)(ws + WS_OA);
    bf16_t* Y = (bf16_t*)(ws + WS_Y);

    {
        PHASE_IDS();
#if PROBE_DUP == 0
#define P0SKIP(rep) ((rep) ? PROBE_DRY : 0)
        for (int rep = 0; rep < 2; ++rep) { float* ada_ = rep ? ctl + 65536 : ada;
#else
#define P0SKIP(rep) 0
        { float* ada_ = ada; const int rep = 0; (void)rep;
#endif
        LAS float* scr = (LAS float*)(lds + wave * 8448);
        constexpr int I_IN = 32 * (INWP / 32), I_UKV = 8 * 64, I_OM = 16 * 64, I_OD = 16 * 64, I_OUT = 32 * 64, I_ADA = 96 * 32;
        constexpr int NTR = I_IN + I_UKV + I_OM + I_OD + I_OUT;
        if (!(P0SKIP(rep) & 1))
        for (int r = gw; r < I_ADA; r += NGW) {
            const int cb = r % 96, kc = r / 96, j = cb * 64 + lane, k0 = kc * 64; float a0 = 0.f, a1 = 0.f;
#pragma unroll
            for (int k = 0; k < 64; ++k) { const float w = A.w_ada[(size_t)(k0 + k) * 6144 + j]; a0 += A.c[k0 + k] * w; a1 += A.c[DM + k0 + k] * w; }
            atomicAdd(ada_ + j, a0); atomicAdd(ada_ + 6144 + j, a1);
        }
#define TR_DECODE(d, it_) do { int r_ = (it_); \
            if (r_ < I_IN) { d.W = A.w_in; d.WT = WIN; d.gk = nullptr; d.kd = 0; d.K = DM; d.N = INW; d.mode = 1; d.k0 = 64 * (r_ % 32); d.n0 = 32 * (r_ / 32); } \
            else if ((r_ -= I_IN) < I_UKV) { d.W = A.w_ukv; d.WT = WUKV; d.gk = A.g_kv; d.kd = 0; d.K = 512; d.N = 2048; d.mode = 2; d.k0 = 64 * (r_ % 8); d.n0 = 32 * (r_ / 8); } \
            else if ((r_ -= I_UKV) < I_OM) { d.W = A.w_o_mla; d.WT = WOM; d.gk = nullptr; d.kd = 0; d.K = 2048; d.N = 2048; d.mode = 0; d.k0 = 64 * (r_ % 16); d.n0 = 32 * (r_ / 16); } \
            else if ((r_ -= I_OM) < I_OD) { d.W = A.w_o_diff; d.WT = WOM; d.gk = nullptr; d.kd = 1024; d.K = 2048; d.N = 2048; d.mode = 0; d.k0 = 64 * (r_ % 16); d.n0 = 32 * (r_ / 16); } \
            else { r_ -= I_OD; d.W = A.w_out; d.WT = WOUT; d.gk = nullptr; d.kd = 0; d.K = 2048; d.N = 2048; d.mode = 0; d.k0 = 64 * (r_ % 32); d.n0 = 32 * (r_ / 32); } } while (0)
        if (!(P0SKIP(rep) & 2)) {
            float va[32], vb[32]; TrDesc da, db; int it = gw;
            if (it < NTR) { TR_DECODE(da, it); tr_load(da, va, lane); }
            while (it < NTR) {
                const int i1 = it + NGW, i2 = it + 2 * NGW;
                if (i1 < NTR) { TR_DECODE(db, i1); tr_load(db, vb, lane); }
                tr_store(da, va, scr, lane);
                if (i1 >= NTR) break;
                if (i2 < NTR) { TR_DECODE(da, i2); tr_load(da, va, lane); }
                tr_store(db, vb, scr, lane);
                it = i2;
            }
        }
#undef TR_DECODE
        if (!(P0SKIP(rep) & 4)) {
            LAS float* invt = (LAS float*)(lds + 8 * 8448);
            __syncthreads();
            if (tid < 32) invt[tid] = powf(10000.0f, -(float)tid / 32.0f);
            __syncthreads();
            for (int e = blockIdx.x * 512 + tid; e < MTOK * 32; e += G * 512) {
                const int t = e >> 5, i = e & 31;
                const float ang = (float)A.pos[t] * invt[i];
                const float k = rintf(ang * 0.6366197723675814f);
                float r = fmaf(-k, 1.5703125f, ang); r = fmaf(-k, 4.837512969970703125e-4f, r); r = fmaf(-k, 7.54978995489188216e-8f, r);
                const float r2 = r * r;
                const float sn = r + r * r2 * (-1.6666667163e-1f + r2 * (8.3333337680e-3f + r2 * (-1.9841270114e-4f + r2 * 2.7557314297e-6f)));
                const float cs = 1.0f + r2 * (-0.5f + r2 * (4.1666667908e-2f + r2 * (-1.3888889225e-3f + r2 * (2.4801587642e-5f + r2 * -2.7557314297e-7f))));
                const int qd = ((int)k) & 3;
                const float s_ = (qd == 0) ? sn : (qd == 1) ? cs : (qd == 2) ? -sn : -cs;
                const float c_ = (qd == 0) ? cs : (qd == 1) ? -sn : (qd == 2) ? -cs : sn;
                ropec[e] = c_; ropes[e] = s_;
            }
        }
        }
    }
    GRID_SYNC();

    {
        PHASE_IDS();
        LAS float* mA = (LAS float*)lds;
        LAS float* mB = mA + 2 * DM;
        for (int e = tid; e < 2 * DM; e += 512) { const int b = e >> 11, n = e & 2047;
            mA[e] = A.g_pre[n] * (1.0f + ada[b * 6144 + 2048 + n] + A.b_ada[2048 + n]); mB[e] = ada[b * 6144 + n] + A.b_ada[n]; }
        __syncthreads();
        for (int m = gw; m < MTOK; m += NGW) {
            const int b = m >> 12; const f32x4* xr = (const f32x4*)(A.x + (size_t)m * DM) + lane;
            f32x4 v[8]; float s = 0.f;
#pragma unroll
            for (int j = 0; j < 8; ++j) { v[j] = xr[64 * j]; s += (v[j][0] * v[j][0] + v[j][1] * v[j][1]) + (v[j][2] * v[j][2] + v[j][3] * v[j][3]); }
            const float rstd = rsqrtf(wave_sum(s) * (1.0f / DM) + EPS);
            u32x2* o8 = (u32x2*)(H + (size_t)m * DM) + lane;
#pragma unroll
            for (int j = 0; j < 8; ++j) { const int n = b * DM + 256 * j + 4 * lane; const f32x4 a = *(const LAS f32x4*)(mA + n), sh = *(const LAS f32x4*)(mB + n);
                u32x2 w; w.x = pk2(v[j][0] * rstd * a[0] + sh[0], v[j][1] * rstd * a[1] + sh[1]); w.y = pk2(v[j][2] * rstd * a[2] + sh[2], v[j][3] * rstd * a[3] + sh[3]);
                o8[64 * j] = w; }
        }
        __syncthreads();
    }
    GRID_SYNC();

#ifndef SKIP_P2
    {
        pg8::Gemm g{H, WIN, MTOK, INWP, DM}; pg8::StaticOrder S; S.init(MTOK, INWP, G, (int)blockIdx.x);
        epi::EpiProj E{QM, CKV, QD, KD, VD, GM, GD, SM, SD, KM, ssqc, ropec, ropes};
        pg8::gemm_phase<epi::EpiProj, pg8::StaticOrder, true, true>(lds, g, S, E);
#if PROBE_DUP == 2
        __syncthreads();
        epi::EpiProj E2{QM, CKV, QD, KD, VD, GM, GD, SM, SD, KM, ctl + 65536, ropec, ropes};
        pg8::gemm_phase<epi::EpiProj, pg8::StaticOrder, true, true>(lds, g, S, E2);
#endif
    }
#endif
    GRID_SYNC();

    {
        pg8::Gemm g{CKV, WUKV, MTOK, 2048, 512}; pg8::StaticOrder S; S.init(MTOK, 2048, G, (int)blockIdx.x);
        epi::EpiUp E{KM, VM, ssqc};
        pg8::gemm_phase<epi::EpiUp, pg8::StaticOrder, true, true>(lds, g, S, E);
    }
    GRID_SYNC();

#ifndef SKIP_P4
    {
        PHASE_IDS();
        att::Ptrs P; P.QM = QM; P.KM = KM; P.VM = VM; P.QD = QD; P.KD = KD; P.VD = VD; P.GM = GM; P.GD = GD; P.OM = OM; P.OD = OD; P.pos = A.pos; P.gsub = A.g_subln;
        { const float s1 = wave_sum(A.lq1[lane] * A.lk1[lane]), s2 = wave_sum(A.lq2[lane] * A.lk2[lane]); P.lam = expf(s1) - expf(s2) + LAMBDA_INIT; }
        LAS unsigned* qslot = (LAS unsigned*)(lds + LDS_MISC);
#define ATT_RUN(M_, b_, h_, qb_) do { const int bad_ = att::attn_unit<M_, false>(lds, (b_), (h_), (qb_), P, rep ? PROBE_DRY : 0); \
            if (__syncthreads_or(bad_)) (void)att::attn_unit<M_, true>(lds, (b_), (h_), (qb_), P, rep ? PROBE_DRY : 0); } while (0)
#if PROBE_DUP == 4
        for (int rep = 0; rep < 2; ++rep)
#else
        const int rep = 0;
#endif
        if (STATIC_PLAN && G == 256) {
            const int x = blockIdx.x & 7, k = blockIdx.x >> 3;
            if (k < 16) { const int bh = 2 * x + (k >> 3), i = k & 7;
                ATT_RUN(true, bh >> 3, bh & 7, 15 - i);
                ATT_RUN(true, bh >> 3, bh & 7, i);
            } else { const int j = k - 16;
#pragma unroll 1
                for (int u = 0; u < 4; ++u) { const int bh = 2 * x + (u & 1), qb = (u < 2) ? 31 - j : j;
                    ATT_RUN(false, bh >> 3, bh & 7, qb); }
            }
        } else
        for (;;) {
            __syncthreads();
            if (tid == 0) *qslot = atomicAdd(queue + rep, 1u);
            __syncthreads();
            int rem = (int)*qslot;
            if (rem >= 768) break;
            int type = -1, qb = 0;
            for (int cv = 160; cv >= 3; --cv) {
                if (cv % 10 == 0) { if (rem < 16) { type = 0; qb = cv / 10 - 1; break; } rem -= 16; }
                if (cv % 3 == 0 && cv <= 96) { if (rem < 16) { type = 1; qb = cv / 3 - 1; break; } rem -= 16; }
            }
            const int b = rem >> 3, h = rem & 7;
            if (type == 0) ATT_RUN(true, b, h, qb);
            else ATT_RUN(false, b, h, qb);
        }
        __syncthreads();
    }
#endif
    GRID_SYNC();

    {
        pg8::StaticOrder S; S.init(MTOK, DM, G, (int)blockIdx.x);
        pg8::Gemm g{OM, WOM, MTOK, DM, 2048}; epi::EpiMerge E{SD, MG}; epi::HookMerge Hk{SM, SD};
        pg8::gemm_phase<epi::EpiMerge, pg8::StaticOrder, true, true, epi::HookMerge>(lds, g, S, E, Hk);
    }
    GRID_SYNC();

    {
        pg8::Gemm g{MG, WOUT, MTOK, DM, DM}; pg8::StaticOrder S; S.init(MTOK, DM, G, (int)blockIdx.x);
        epi::EpiOut E{Y, ssqy};
        pg8::gemm_phase<epi::EpiOut, pg8::StaticOrder, true, true>(lds, g, S, E);
    }
    GRID_SYNC();

    {
        PHASE_IDS();
        LAS float* gg = (LAS float*)lds;
        for (int e = tid; e < 2 * DM; e += 512) { const int b = e >> 11, n = e & 2047; gg[e] = (ada[b * 6144 + 4096 + n] + A.b_ada[4096 + n]) * A.g_post[n]; }
        __syncthreads();
        for (int m = gw; m < MTOK; m += NGW) {
            const int b = m >> 12; const float rstd = rsqrtf(ssqy[m] * (1.0f / DM) + EPS);
            const f32x4* xr = (const f32x4*)(A.x + (size_t)m * DM) + lane; const u32x2* yr = (const u32x2*)(Y + (size_t)m * DM) + lane; f32x4* orow = (f32x4*)(A.out + (size_t)m * DM) + lane;
#pragma unroll
            for (int j = 0; j < 8; ++j) { const f32x4 g4 = *(const LAS f32x4*)(gg + b * DM + 256 * j + 4 * lane); const u32x2 yy = yr[64 * j]; const f32x4 y4 = {bflo(yy.x), bfhi(yy.x), bflo(yy.y), bfhi(yy.y)};
                orow[64 * j] = xr[64 * j] + y4 * g4 * rstd; }
        }
    }
}

extern "C" void kernel_launch(void* const* d_in, const int* in_sizes, int n_in, void* d_out, int out_size, void* d_ws, size_t ws_size, hipStream_t stream) {
    static int grid_blocks = 0;
    if (grid_blocks == 0) {
        if (n_in != 18 || in_sizes[0] != MTOK * DM || out_size != MTOK * DM || ws_size < WS_END) { fprintf(stderr, "kernel_launch: unexpected shapes (n_in %d, in0 %d, out %d, ws %zu)\n", n_in, n_in > 0 ? in_sizes[0] : -1, out_size, ws_size); grid_blocks = -1; return; }
        int dev = 0, cus = 0, per_cu = 0;
        (void)hipGetDevice(&dev); (void)hipDeviceGetAttribute(&cus, hipDeviceAttributeMultiprocessorCount, dev);
        if (hipFuncSetAttribute((const void*)fwd_kernel, hipFuncAttributeMaxDynamicSharedMemorySize, LDS_BYTES) != hipSuccess) { fprintf(stderr, "kernel_launch: hipFuncSetAttribute failed\n"); grid_blocks = -1; return; }
        if (hipOccupancyMaxActiveBlocksPerMultiprocessor(&per_cu, (const void*)fwd_kernel, 512, LDS_BYTES) != hipSuccess || per_cu < 1) { fprintf(stderr, "kernel_launch: occupancy query says %d\n", per_cu); per_cu = 1; }
        (void)hipGetLastError();
        grid_blocks = cus;
    }
    if (grid_blocks < 0) return;
    (void)hipMemsetAsync((char*)d_ws + WS_CTL, 0, CTL_BYTES, stream);
    Args a{};
    a.x = (const float*)d_in[0]; a.c = (const float*)d_in[1]; a.pos = (const int*)d_in[2]; a.w_ada = (const float*)d_in[3]; a.b_ada = (const float*)d_in[4]; a.g_pre = (const float*)d_in[5];
    a.w_in = (const float*)d_in[6]; a.g_kv = (const float*)d_in[7]; a.w_ukv = (const float*)d_in[8]; a.lq1 = (const float*)d_in[9]; a.lk1 = (const float*)d_in[10]; a.lq2 = (const float*)d_in[11]; a.lk2 = (const float*)d_in[12];
    a.g_subln = (const float*)d_in[13]; a.w_o_mla = (const float*)d_in[14]; a.w_o_diff = (const float*)d_in[15]; a.w_out = (const float*)d_in[16]; a.g_post = (const float*)d_in[17];
    a.out = (float*)d_out; a.ws = (unsigned char*)d_ws;
    void* args[] = {&a};
    hipError_t e = hipLaunchCooperativeKernel((const void*)fwd_kernel, dim3(grid_blocks), dim3(512), args, LDS_BYTES, stream);
    if (e != hipSuccess) fprintf(stderr, "cooperative launch failed: %s (grid %d)\n", hipGetErrorString(e), grid_blocks);
}
```

```cpp
#include <hip/hip_runtime.h>
#include <hip/hip_cooperative_groups.h>
#include <cstdio>
#include <cstdint>
namespace pg8 {
#define PG8_LAS __attribute__((address_space(3)))
typedef unsigned short bf16_t;
typedef short bf16x8 __attribute__((ext_vector_type(8)));
typedef float f32x4 __attribute__((ext_vector_type(4)));
typedef unsigned u32x4 __attribute__((ext_vector_type(4)));
constexpr int BM = 256, BK = 64, HALF = 128, HTB = HALF * BK * 2  , STAGE_BYTES = 8 * HTB, NXCD = 8, WGM = 8;

__host__ __device__ __forceinline__ int lds_byte(int r, int c) { const int st = (r >> 4) * 2 + (c >> 5), rr = r & 15, cc = c & 31, ob = rr * 64 + cc * 2; return st * 1024 + (ob ^ (((ob >> 9) & 1) << 5)); }
__host__ __device__ __forceinline__ void stage_rc(int b, int& R, int& C) { const int st = b / 1024, sb = b % 1024, swz = sb ^ (((sb >> 9) & 1) << 5); R = (st >> 1) * 16 + swz / 64; C = (st & 1) * 32 + (swz % 64) / 2; }
__host__ __device__ __forceinline__ int perm32(int rho) { const int n = rho >> 4, i = rho & 15; return 8 * (i >> 2) + 4 * n + (i & 3); }

struct Unit { int pm, pn; };
struct Gemm { const bf16_t* A; const bf16_t* Bt; int M, N, K; };

struct StaticOrder {
    int nM, nN, nwg, G, c;
    __host__ __device__ void init(int M, int N, int G_, int c_) { nM = M / BM; nN = N / BM; nwg = nM * nN; G = G_; c = c_; }
    __host__ __device__ bool next(int i, Unit& u) const {
        const long L = (long)i * G + c; if (L >= nwg) return false;
        int wgid = (int)L; { const int q = nwg / NXCD, r = nwg % NXCD, xcd = wgid % NXCD, off = wgid / NXCD; wgid = (xcd < r ? xcd * (q + 1) : r * (q + 1) + (xcd - r) * q) + off; }
        const int nig = WGM * nN, gid = wgid / nig, fm = gid * WGM, gsz = (nM - fm) < WGM ? (nM - fm) : WGM;
        u.pm = fm + ((wgid % nig) % gsz); u.pn = (wgid % nig) / gsz; return true;
    }
    __device__ __forceinline__ void a_ready(const Unit&) const {}
    __device__ __forceinline__ void done(const Unit&) const {}
};

__device__ __forceinline__ unsigned cvt_pk_bf16(float lo, float hi) { unsigned r; asm volatile("v_cvt_pk_bf16_f32 %0, %1, %2" : "=v"(r) : "v"(lo), "v"(hi)); return r; }
struct NoHook { static constexpr bool ON = false; static constexpr int T = 0; template <class A_> __device__ __forceinline__ void mid(A_&, const Unit&, int, int, int, int) const {} };
template <class Epi, class Sched, bool ALIGN_EPI = false, bool SP2 = false, class Hook = NoHook>
__device__ __forceinline__ void gemm_phase(PG8_LAS unsigned char* lds, const Gemm g, const Sched& S, const Epi& E, const Hook& H = Hook()) {
    int tid_ = threadIdx.x; asm volatile("" : "+v"(tid_));
    const int tid = tid_, wid = __builtin_amdgcn_readfirstlane(tid >> 6), lane = tid & 63, wr = wid >> 2, wc = wid & 3, fr = lane & 15, fq = lane >> 4;
    const int K = g.K, nt = K / BK;
    unsigned voffA[2], voffB[2];
#pragma unroll
    for (int i = 0; i < 2; ++i) { int R, C; stage_rc(tid * 16 + i * 8192, R, C); const int Rb = Epi::PERM ? ((R & ~31) + perm32(R & 31)) : R;
        voffA[i] = (unsigned)(R * K + C) * 2u; voffB[i] = (unsigned)(Rb * K + C) * 2u; }
    const size_t kstep = (size_t)(BK * 2);
    const size_t hstep = (size_t)HALF * K * 2;
    const size_t tstep = 2 * hstep;
    const unsigned ldsw = (unsigned)wid * 1024u;
    const int aoff = lds_byte(wr * 64 + fr, fq * 8), boff = lds_byte(wc * 32 + fr, fq * 8);
#define PG8_SA(b, h) (((b) * 2 + (h)) * HTB)
#define PG8_SB(b, h) ((4 + (b) * 2 + (h)) * HTB)
#define PG8_STAGE(bufoff, gbase, voff) do { _Pragma("unroll") for (int _i = 0; _i < 2; ++_i) \
        __builtin_amdgcn_global_load_lds((const unsigned*)((const char*)(gbase) + (voff)[_i]), (PG8_LAS unsigned*)(lds + (bufoff) + ldsw + _i * 8192), 16, 0, 0); } while (0)
#define PG8_LDA(dst, b, h) do { _Pragma("unroll") for (int m = 0; m < 4; ++m) _Pragma("unroll") for (int k = 0; k < 2; ++k) dst[m][k] = *(const PG8_LAS bf16x8*)(lds + PG8_SA(b, h) + aoff + m * 2048 + k * 1024); } while (0)
#define PG8_LDB(dst, b, h) do { _Pragma("unroll") for (int n = 0; n < 2; ++n) _Pragma("unroll") for (int k = 0; k < 2; ++k) dst[n][k] = *(const PG8_LAS bf16x8*)(lds + PG8_SB(b, h) + boff + n * 2048 + k * 1024); } while (0)
#define PG8_MMA(ai, bj, At, Bt) do { __builtin_amdgcn_s_setprio(1); _Pragma("unroll") for (int m = 0; m < 4; ++m) _Pragma("unroll") for (int n = 0; n < 2; ++n) _Pragma("unroll") for (int k = 0; k < 2; ++k) \
        acc[ai][bj][m][n] = __builtin_amdgcn_mfma_f32_16x16x32_bf16(Bt[n][k], At[m][k], acc[ai][bj][m][n], 0, 0, 0); __builtin_amdgcn_s_setprio(0); } while (0)
#define PG8_WAIT_V(n) asm volatile("s_waitcnt vmcnt(" #n ")" ::: "memory")
#define PG8_WAIT_L(n) asm volatile("s_waitcnt lgkmcnt(" #n ")" ::: "memory")
#define PG8_BAR __builtin_amdgcn_s_barrier()
#define PG8_SCHED __builtin_amdgcn_sched_barrier(0)
    Unit cur, nxt; int ui = 0;
    if (!S.next(0, cur)) return;
    f32x4 acc[2][2][4][2];
#pragma unroll
    for (int a = 0; a < 2; ++a)
#pragma unroll
        for (int b = 0; b < 2; ++b)
#pragma unroll
            for (int m = 0; m < 4; ++m)
#pragma unroll
                for (int n = 0; n < 2; ++n) acc[a][b][m][n] = (f32x4){0.f, 0.f, 0.f, 0.f};
    bf16x8 At[4][2], B0[2][2], B1[2][2];
    const char* cA = (const char*)g.A + (size_t)cur.pm * tstep; const char* cB = (const char*)g.Bt + (size_t)cur.pn * tstep;
    S.a_ready(cur);
    if constexpr (SP2) {
        PG8_STAGE(PG8_SB(0, 0), cB, voffB); PG8_STAGE(PG8_SB(0, 1), cB + hstep, voffB); PG8_STAGE(PG8_SA(0, 0), cA, voffA); PG8_STAGE(PG8_SA(0, 1), cA + hstep, voffA);
        if (wr == 1) PG8_BAR;
        PG8_WAIT_V(2); PG8_BAR;
        PG8_STAGE(PG8_SB(1, 0), cB + kstep, voffB); PG8_STAGE(PG8_SA(1, 0), cA + kstep, voffA); PG8_STAGE(PG8_SB(1, 1), cB + hstep + kstep, voffB);
        PG8_WAIT_V(6); PG8_BAR;
    } else {
        PG8_STAGE(PG8_SB(0, 0), cB, voffB); PG8_STAGE(PG8_SA(0, 0), cA, voffA); PG8_STAGE(PG8_SB(0, 1), cB + hstep, voffB); PG8_STAGE(PG8_SA(0, 1), cA + hstep, voffA);
        if (wr == 1) PG8_BAR;
        PG8_WAIT_V(4); PG8_BAR;
        PG8_STAGE(PG8_SB(1, 0), cB + kstep, voffB); PG8_STAGE(PG8_SA(1, 0), cA + kstep, voffA); PG8_STAGE(PG8_SB(1, 1), cB + hstep + kstep, voffB);
        PG8_WAIT_V(6); PG8_BAR;
    }
    for (;;) {
        const bool has_next = S.next(ui + 1, nxt);
        const char* nA = has_next ? (const char*)g.A + (size_t)nxt.pm * tstep : cA; const char* nB = has_next ? (const char*)g.Bt + (size_t)nxt.pn * tstep : cB;
        for (int t = 0; t < nt; t += 2) {
            const bool last = (t == nt - 2);
            const char* a1 = cA + (size_t)(t + 1) * kstep;
            const char* a2 = last ? nA : cA + (size_t)(t + 2) * kstep; const char* b2 = last ? nB : cB + (size_t)(t + 2) * kstep;
            const char* a3 = a2 + kstep; const char* b3 = b2 + kstep;
            if (last && has_next) S.a_ready(nxt);
            if constexpr (Hook::ON) { if (t == Hook::T) H.mid(acc, cur, wr, wc, fr, fq); }
            if constexpr (SP2) {
            PG8_LDB(B0, 0, 0); PG8_LDB(B1, 0, 1); PG8_SCHED; PG8_LDA(At, 0, 0); PG8_STAGE(PG8_SA(1, 1), a1 + hstep, voffA);
            PG8_WAIT_V(8); PG8_WAIT_L(0); PG8_BAR; PG8_MMA(0, 0, At, B0); PG8_MMA(0, 1, At, B1); PG8_BAR; PG8_SCHED;
            PG8_LDA(At, 0, 1); PG8_STAGE(PG8_SB(0, 0), b2, voffB); PG8_STAGE(PG8_SB(0, 1), b2 + hstep, voffB); PG8_STAGE(PG8_SA(0, 0), a2, voffA);
            PG8_WAIT_V(8); PG8_WAIT_L(0); PG8_BAR; PG8_MMA(1, 0, At, B0); PG8_MMA(1, 1, At, B1); PG8_BAR; PG8_SCHED;
            PG8_LDB(B0, 1, 0); PG8_LDB(B1, 1, 1); PG8_SCHED; PG8_LDA(At, 1, 0); PG8_STAGE(PG8_SA(0, 1), a2 + hstep, voffA);
            PG8_WAIT_V(8); PG8_WAIT_L(0); PG8_BAR; PG8_MMA(0, 0, At, B0); PG8_MMA(0, 1, At, B1); PG8_BAR; PG8_SCHED;
            PG8_LDA(At, 1, 1); PG8_STAGE(PG8_SB(1, 0), b3, voffB); PG8_STAGE(PG8_SB(1, 1), b3 + hstep, voffB); PG8_STAGE(PG8_SA(1, 0), a3, voffA);
            PG8_WAIT_V(8); PG8_WAIT_L(0); PG8_BAR; PG8_MMA(1, 0, At, B0); PG8_MMA(1, 1, At, B1); PG8_BAR; PG8_SCHED;
            } else {
            PG8_LDB(B0, 0, 0); PG8_SCHED; PG8_LDA(At, 0, 0); PG8_STAGE(PG8_SA(1, 1), a1 + hstep, voffA);
            PG8_WAIT_L(8); PG8_BAR; PG8_WAIT_L(0); PG8_MMA(0, 0, At, B0); PG8_BAR; PG8_SCHED;
            PG8_LDB(B1, 0, 1); PG8_STAGE(PG8_SB(0, 0), b2, voffB);
            PG8_BAR; PG8_WAIT_L(0); PG8_MMA(0, 1, At, B1); PG8_BAR;
            PG8_LDA(At, 0, 1); PG8_STAGE(PG8_SA(0, 0), a2, voffA);
            PG8_BAR; PG8_WAIT_L(0); PG8_MMA(1, 0, At, B0); PG8_BAR; PG8_SCHED;
            PG8_STAGE(PG8_SB(0, 1), b2 + hstep, voffB);
            PG8_WAIT_V(6); PG8_BAR; PG8_MMA(1, 1, At, B1); PG8_BAR;
            PG8_LDB(B0, 1, 0); PG8_SCHED; PG8_LDA(At, 1, 0); PG8_STAGE(PG8_SA(0, 1), a2 + hstep, voffA);
            PG8_WAIT_L(8); PG8_BAR; PG8_WAIT_L(0); PG8_MMA(0, 0, At, B0); PG8_BAR; PG8_SCHED;
            PG8_LDB(B1, 1, 1); PG8_STAGE(PG8_SB(1, 0), b3, voffB);
            PG8_BAR; PG8_WAIT_L(0); PG8_MMA(0, 1, At, B1); PG8_BAR;
            PG8_LDA(At, 1, 1); PG8_STAGE(PG8_SA(1, 0), a3, voffA);
            PG8_BAR; PG8_WAIT_L(0); PG8_MMA(1, 0, At, B0); PG8_BAR; PG8_SCHED;
            PG8_STAGE(PG8_SB(1, 1), b3 + hstep, voffB);
            PG8_WAIT_V(6); PG8_BAR; PG8_MMA(1, 1, At, B1); PG8_BAR;
            }
        }
        if constexpr (ALIGN_EPI) { if (wr == 0) PG8_BAR; }
        if constexpr (!Epi::AFTER_DRAIN) { E(acc, cur, wr, wc, fr, fq); S.done(cur); }
        if (!has_next) break;
#pragma unroll
        for (int a = 0; a < 2; ++a)
#pragma unroll
            for (int b = 0; b < 2; ++b)
#pragma unroll
                for (int m = 0; m < 4; ++m)
#pragma unroll
                    for (int n = 0; n < 2; ++n) acc[a][b][m][n] = (f32x4){0.f, 0.f, 0.f, 0.f};
        cur = nxt; cA = nA; cB = nB; ++ui;
        if constexpr (ALIGN_EPI) { if (wr == 1) PG8_BAR; }
    }
    PG8_WAIT_V(0);
    if constexpr (!ALIGN_EPI) { if (wr == 0) PG8_BAR; }
    PG8_BAR;
    if constexpr (Epi::AFTER_DRAIN) { E.fused(acc, cur, wr, wc, fr, fq, lds, wid, lane); S.done(cur); }
#undef PG8_SA
#undef PG8_SB
#undef PG8_STAGE
#undef PG8_LDA
#undef PG8_LDB
#undef PG8_MMA
#undef PG8_WAIT_V
#undef PG8_WAIT_L
#undef PG8_BAR
#undef PG8_SCHED
}
}

namespace cg = cooperative_groups;
#ifndef PROBE_DUP
#define PROBE_DUP -1
#endif
#ifndef PROBE_DRY
#define PROBE_DRY 0
#endif
#ifndef STATIC_PLAN
#define STATIC_PLAN 0
#endif
#define LAS __attribute__((address_space(3)))
typedef unsigned short bf16_t;
typedef short bf16x8 __attribute__((ext_vector_type(8)));
typedef short s16x4 __attribute__((ext_vector_type(4)));
typedef float f32x4 __attribute__((ext_vector_type(4)));
typedef float f32x16 __attribute__((ext_vector_type(16)));
typedef unsigned u32x4 __attribute__((ext_vector_type(4)));
typedef unsigned u32x2 __attribute__((ext_vector_type(2)));

constexpr int DM = 2048, NB = 2, SEQ = 4096, MTOK = NB * SEQ;
constexpr int INW = 11328, INWP = 11520;
constexpr float EPS = 1e-6f;
constexpr float LOG2E = 1.4426950408889634f;
constexpr float QS_MLA = 0.07216878364870322f * LOG2E;
constexpr float QS_DIF = 0.125f * LOG2E;
constexpr float LAMBDA_INIT = 0.2f;

constexpr size_t MiB = 1u << 20;
constexpr size_t WS_CTL = 0;
constexpr size_t CTL_BYTES = 1 * MiB;
constexpr size_t WS_ROPE = 2 * MiB;
constexpr size_t WS_WUKV = 4 * MiB, WS_WOM = 6 * MiB, WS_WOD = 10 * MiB, WS_WOUT = 14 * MiB, WS_WIN = 22 * MiB;
constexpr size_t WS_H = 67 * MiB;
constexpr size_t WS_QM = 99 * MiB, WS_CKV = 123 * MiB, WS_KM = 131 * MiB, WS_VM = 155 * MiB;
constexpr size_t WS_QD = 171 * MiB, WS_KD = 187 * MiB, WS_VD = 203 * MiB, WS_GM = 219 * MiB, WS_GD = 235 * MiB;
constexpr size_t WS_SM = 251 * MiB, WS_SD = 283 * MiB, WS_OA = 315 * MiB, WS_END = 347 * MiB;
constexpr size_t WS_Y = 99 * MiB;
constexpr int CTL_BAR = 32768;
constexpr int CTL_SSQC = 0, CTL_SSQY = 8192, CTL_ADA = 16384, CTL_QUEUE = 16384 + 12288;

constexpr int LDS_MAIN = 131072, LDS_MISC = 131072, LDS_BYTES = 135168;

__device__ __forceinline__ unsigned f2bf(float f) { unsigned u = __builtin_bit_cast(unsigned, f); return (u + 0x7fffu + ((u >> 16) & 1u)) >> 16; }
typedef float f32x2_t __attribute__((ext_vector_type(2))); typedef __bf16 bf16x2_t __attribute__((ext_vector_type(2)));
__device__ __forceinline__ unsigned pk2(float lo, float hi) { f32x2_t v = {lo, hi}; bf16x2_t b = __builtin_convertvector(v, bf16x2_t); return __builtin_bit_cast(unsigned, b); }
__device__ __forceinline__ float fexp2(float v) { return __builtin_amdgcn_exp2f(v); }
__device__ __forceinline__ float bf2f(unsigned short b) { return __builtin_bit_cast(float, (unsigned)b << 16); }
__device__ __forceinline__ float bflo(unsigned w) { return __builtin_bit_cast(float, w << 16); }
__device__ __forceinline__ float bfhi(unsigned w) { return __builtin_bit_cast(float, w & 0xffff0000u); }
__device__ __forceinline__ float wave_sum(float v) {
#pragma unroll
    for (int o = 1; o < 64; o <<= 1) v += __shfl_xor(v, o);
    return v;
}
__device__ __forceinline__ float fsigmoid(float v) { return __builtin_amdgcn_rcpf(1.0f + fexp2(-1.4426950408889634f * v)); }

__device__ __forceinline__ int vsrc_in(int v) {
    if (v < 1536) { const int hd = v / 192, w = v - hd * 192; if (w < 128) return v; const int r = w - 128; return hd * 192 + 128 + (r >> 1) + 32 * (r & 1); }
    if (v < 2048) return v;
    if (v < 11264) return v + 64;
    if (v < 11328) { const int r = v - 11264; return 2048 + (r >> 1) + 32 * (r & 1); }
    return -1;
}

namespace epi {
using pg8::Unit;
__device__ __forceinline__ void st8(bf16_t* p, f32x4 a, f32x4 b) {
    u32x4 w; w.x = pk2(a[0], a[1]); w.y = pk2(a[2], a[3]); w.z = pk2(b[0], b[1]); w.w = pk2(b[2], b[3]); *(u32x4*)p = w;
}
__device__ __forceinline__ void rope8(f32x4& v0, f32x4& v1, const float* rc, const float* rs) {
    const f32x4 c4 = *(const f32x4*)rc, s4 = *(const f32x4*)rs;
    f32x4 a, b;
    a[0] = v0[0] * c4[0] - v0[1] * s4[0]; a[1] = v0[1] * c4[0] + v0[0] * s4[0];
    a[2] = v0[2] * c4[1] - v0[3] * s4[1]; a[3] = v0[3] * c4[1] + v0[2] * s4[1];
    b[0] = v1[0] * c4[2] - v1[1] * s4[2]; b[1] = v1[1] * c4[2] + v1[0] * s4[2];
    b[2] = v1[2] * c4[3] - v1[3] * s4[3]; b[3] = v1[3] * c4[3] + v1[2] * s4[3];
    v0 = a; v1 = b;
}
template <int ACT> __device__ __forceinline__ void store_tile(const f32x4 (&acc)[2][2][4][2], bf16_t* dst, int ldc, int colt, int rowb, int colw, float sc) {
#pragma unroll
    for (int ai = 0; ai < 2; ++ai)
#pragma unroll
        for (int m = 0; m < 4; ++m) { bf16_t* rowp = dst + (size_t)(rowb + ai * 128 + m * 16) * ldc + colt + colw;
#pragma unroll
            for (int bj = 0; bj < 2; ++bj) { f32x4 v0 = acc[ai][bj][m][0], v1 = acc[ai][bj][m][1];
                if (ACT == 1) { v0 = v0 * sc; v1 = v1 * sc; }
                if (ACT == 2) {
#pragma unroll
                    for (int i = 0; i < 4; ++i) { v0[i] = v0[i] * fsigmoid(v0[i]); v1[i] = v1[i] * fsigmoid(v1[i]); } }
                if (ACT == 3) {
#pragma unroll
                    for (int i = 0; i < 4; ++i) { v0[i] = fsigmoid(v0[i]); v1[i] = fsigmoid(v1[i]); } }
                st8(rowp + bj * 128, v0, v1); } }
}

struct EpiProj {
    static constexpr bool PERM = true, AFTER_DRAIN = false;
    bf16_t *QM, *CKV, *QD, *KD, *VD, *GM, *GD, *SM, *SD, *KM; float* ssq; const float* rc; const float* rs;
    __device__ __forceinline__ void operator()(const f32x4 (&acc)[2][2][4][2], const Unit& u, int wr, int wc, int fr, int fq) const {
        const int pn = u.pn, rowb = u.pm * 256 + wr * 64 + fr, colw = wc * 32 + 8 * fq;
        if (pn < 6) {
#pragma unroll
            for (int bj = 0; bj < 2; ++bj) { const int col = pn * 256 + bj * 128 + colw, w = col % 192; const bool rp = w >= 128; const int i0 = (w - 128) >> 1;
#pragma unroll
                for (int ai = 0; ai < 2; ++ai)
#pragma unroll
                    for (int m = 0; m < 4; ++m) { const int row = rowb + ai * 128 + m * 16; f32x4 v0 = acc[ai][bj][m][0], v1 = acc[ai][bj][m][1];
                        if (rp) rope8(v0, v1, rc + (size_t)row * 32 + i0, rs + (size_t)row * 32 + i0);
                        v0 = v0 * QS_MLA; v1 = v1 * QS_MLA; st8(QM + (size_t)row * 1536 + col, v0, v1); } }
        } else if (pn < 8) {
            const int colt = (pn - 6) * 256;
#pragma unroll
            for (int ai = 0; ai < 2; ++ai)
#pragma unroll
                for (int m = 0; m < 4; ++m) { const int row = rowb + ai * 128 + m * 16; float s = 0.f;
#pragma unroll
                    for (int bj = 0; bj < 2; ++bj) { const f32x4 v0 = acc[ai][bj][m][0], v1 = acc[ai][bj][m][1];
                        s += (v0[0] * v0[0] + v0[1] * v0[1]) + (v0[2] * v0[2] + v0[3] * v0[3]) + (v1[0] * v1[0] + v1[1] * v1[1]) + (v1[2] * v1[2] + v1[3] * v1[3]);
                        st8(CKV + (size_t)row * 512 + colt + bj * 128 + colw, v0, v1); }
                    s += __shfl_xor(s, 16); s += __shfl_xor(s, 32);
                    if (fq == 0) atomicAdd(ssq + row, s); }
        } else if (pn < 12) store_tile<1>(acc, QD, 1024, (pn - 8) * 256, rowb, colw, QS_DIF);
        else if (pn < 16) store_tile<0>(acc, KD, 1024, (pn - 12) * 256, rowb, colw, 1.f);
        else if (pn < 20) store_tile<0>(acc, VD, 1024, (pn - 16) * 256, rowb, colw, 1.f);
        else if (pn < 24) store_tile<2>(acc, GM, 1024, (pn - 20) * 256, rowb, colw, 1.f);
        else if (pn < 28) store_tile<2>(acc, GD, 1024, (pn - 24) * 256, rowb, colw, 1.f);
        else if (pn < 36) store_tile<3>(acc, SM, 2048, (pn - 28) * 256, rowb, colw, 1.f);
        else if (pn < 44) store_tile<3>(acc, SD, 2048, (pn - 36) * 256, rowb, colw, 1.f);
        else {
            if (wc < 2) { const int i0 = colw >> 1;
#pragma unroll
                for (int ai = 0; ai < 2; ++ai)
#pragma unroll
                    for (int m = 0; m < 4; ++m) { const int row = rowb + ai * 128 + m * 16; f32x4 v0 = acc[ai][0][m][0], v1 = acc[ai][0][m][1];
                        rope8(v0, v1, rc + (size_t)row * 32 + i0, rs + (size_t)row * 32 + i0);
                        const int b = row >> 12, s = row & 4095;
#pragma unroll
                        for (int h = 0; h < 8; ++h) st8(KM + ((size_t)(b * 8 + h) * SEQ + s) * 192 + 128 + colw, v0, v1); } }
        }
    }
};
struct EpiUp {
    static constexpr bool PERM = true, AFTER_DRAIN = false;
    bf16_t *KM, *VM; const float* ssq;
    __device__ __forceinline__ void operator()(const f32x4 (&acc)[2][2][4][2], const Unit& u, int wr, int wc, int fr, int fq) const {
        const int h = u.pn, rowb = u.pm * 256 + wr * 64 + fr, colw = wc * 32 + 8 * fq;
#pragma unroll
        for (int ai = 0; ai < 2; ++ai)
#pragma unroll
            for (int m = 0; m < 4; ++m) { const int row = rowb + ai * 128 + m * 16; const float r = rsqrtf(ssq[row] * (1.0f / 512.0f) + EPS);
                const int b = row >> 12, s = row & 4095;
                st8(KM + ((size_t)(b * 8 + h) * SEQ + s) * 192 + colw, acc[ai][0][m][0] * r, acc[ai][0][m][1] * r);
                st8(VM + (size_t)row * 1024 + h * 128 + colw, acc[ai][1][m][0] * r, acc[ai][1][m][1] * r); }
    }
};
struct EpiO1 {
    static constexpr bool PERM = true, AFTER_DRAIN = false;
    bf16_t* Y; const bf16_t* S;
    __device__ __forceinline__ void operator()(const f32x4 (&acc)[2][2][4][2], const Unit& u, int wr, int wc, int fr, int fq) const {
        const int rowb = u.pm * 256 + wr * 64 + fr, colb = u.pn * 256 + wc * 32 + 8 * fq;
#pragma unroll
        for (int ai = 0; ai < 2; ++ai)
#pragma unroll
            for (int m = 0; m < 4; ++m)
#pragma unroll
                for (int bj = 0; bj < 2; ++bj) { const size_t off = (size_t)(rowb + ai * 128 + m * 16) * DM + colb + bj * 128;
                    const u32x4 g = *(const u32x4*)(S + off); f32x4 v0 = acc[ai][bj][m][0], v1 = acc[ai][bj][m][1];
                    v0[0] *= bflo(g.x); v0[1] *= bfhi(g.x); v0[2] *= bflo(g.y); v0[3] *= bfhi(g.y); v1[0] *= bflo(g.z); v1[1] *= bfhi(g.z); v1[2] *= bflo(g.w); v1[3] *= bfhi(g.w);
                    st8(Y + off, v0, v1); }
    }
};
struct EpiO2 {
    static constexpr bool PERM = true, AFTER_DRAIN = false;
    const bf16_t* Y; const bf16_t* S; bf16_t* MG;
    __device__ __forceinline__ void operator()(const f32x4 (&acc)[2][2][4][2], const Unit& u, int wr, int wc, int fr, int fq) const {
        const int rowb = u.pm * 256 + wr * 64 + fr, colb = u.pn * 256 + wc * 32 + 8 * fq;
#pragma unroll
        for (int ai = 0; ai < 2; ++ai)
#pragma unroll
            for (int m = 0; m < 4; ++m)
#pragma unroll
                for (int bj = 0; bj < 2; ++bj) { const size_t off = (size_t)(rowb + ai * 128 + m * 16) * DM + colb + bj * 128;
                    const u32x4 g = *(const u32x4*)(S + off); f32x4 v0 = acc[ai][bj][m][0], v1 = acc[ai][bj][m][1];
                    const u32x4 yy = *(const u32x4*)(Y + off); const f32x4 y0 = {bflo(yy.x), bfhi(yy.x), bflo(yy.y), bfhi(yy.y)}, y1 = {bflo(yy.z), bfhi(yy.z), bflo(yy.w), bfhi(yy.w)};
                    v0[0] = y0[0] + v0[0] * bflo(g.x); v0[1] = y0[1] + v0[1] * bfhi(g.x); v0[2] = y0[2] + v0[2] * bflo(g.y); v0[3] = y0[3] + v0[3] * bfhi(g.y);
                    v1[0] = y1[0] + v1[0] * bflo(g.z); v1[1] = y1[1] + v1[1] * bfhi(g.z); v1[2] = y1[2] + v1[2] * bflo(g.w); v1[3] = y1[3] + v1[3] * bfhi(g.w);
                    st8(MG + off, v0, v1); }
    }
};
struct HookMerge {
    static constexpr bool ON = true; static constexpr int T = 16;
    const bf16_t *SMp, *SDp;
    __device__ __forceinline__ void mid(f32x4 (&acc)[2][2][4][2], const Unit& u, int wr, int wc, int fr, int fq) const {
        int rowb = u.pm * 256 + wr * 64 + fr, colb = u.pn * 256 + wc * 32 + 8 * fq;
        asm volatile("" : "+v"(rowb), "+v"(colb));
#pragma unroll
        for (int ai = 0; ai < 2; ++ai)
#pragma unroll
            for (int m = 0; m < 4; ++m) {
#pragma unroll
                for (int bj = 0; bj < 2; ++bj) { const size_t off = (size_t)(rowb + ai * 128 + m * 16) * DM + colb + bj * 128;
                    const u32x4 a = *(const u32x4*)(SMp + off), d = *(const u32x4*)(SDp + off);
                    f32x4 r0, r1;
                    r0[0] = bflo(a.x) * __builtin_amdgcn_rcpf(bflo(d.x)); r0[1] = bfhi(a.x) * __builtin_amdgcn_rcpf(bfhi(d.x)); r0[2] = bflo(a.y) * __builtin_amdgcn_rcpf(bflo(d.y)); r0[3] = bfhi(a.y) * __builtin_amdgcn_rcpf(bfhi(d.y));
                    r1[0] = bflo(a.z) * __builtin_amdgcn_rcpf(bflo(d.z)); r1[1] = bfhi(a.z) * __builtin_amdgcn_rcpf(bfhi(d.z)); r1[2] = bflo(a.w) * __builtin_amdgcn_rcpf(bflo(d.w)); r1[3] = bfhi(a.w) * __builtin_amdgcn_rcpf(bfhi(d.w));
                    acc[ai][bj][m][0] = acc[ai][bj][m][0] * r0; acc[ai][bj][m][1] = acc[ai][bj][m][1] * r1; }
                if (m & 1) asm volatile("" ::: "memory");
            }
    }
};
struct EpiMerge {
    static constexpr bool PERM = true, AFTER_DRAIN = false;
    const bf16_t* S; bf16_t* MG;
    __device__ __forceinline__ void operator()(const f32x4 (&acc)[2][2][4][2], const Unit& u, int wr, int wc, int fr, int fq) const {
        const int rowb = u.pm * 256 + wr * 64 + fr, colb = u.pn * 256 + wc * 32 + 8 * fq;
#pragma unroll
        for (int ai = 0; ai < 2; ++ai)
#pragma unroll
            for (int m = 0; m < 4; ++m)
#pragma unroll
                for (int bj = 0; bj < 2; ++bj) { const size_t off = (size_t)(rowb + ai * 128 + m * 16) * DM + colb + bj * 128;
                    const u32x4 g = *(const u32x4*)(S + off); f32x4 v0 = acc[ai][bj][m][0], v1 = acc[ai][bj][m][1];
                    v0[0] *= bflo(g.x); v0[1] *= bfhi(g.x); v0[2] *= bflo(g.y); v0[3] *= bfhi(g.y); v1[0] *= bflo(g.z); v1[1] *= bfhi(g.z); v1[2] *= bflo(g.w); v1[3] *= bfhi(g.w);
                    st8(MG + off, v0, v1); }
    }
};
struct EpiOut {
    static constexpr bool PERM = true, AFTER_DRAIN = false;
    bf16_t* Y; float* ssq;
    __device__ __forceinline__ void operator()(const f32x4 (&acc)[2][2][4][2], const Unit& u, int wr, int wc, int fr, int fq) const {
        const int rowb = u.pm * 256 + wr * 64 + fr, colb = u.pn * 256 + wc * 32 + 8 * fq;
#pragma unroll
        for (int ai = 0; ai < 2; ++ai)
#pragma unroll
            for (int m = 0; m < 4; ++m) { const int row = rowb + ai * 128 + m * 16; float s = 0.f;
#pragma unroll
                for (int bj = 0; bj < 2; ++bj) { const size_t off = (size_t)row * DM + colb + bj * 128; const f32x4 v0 = acc[ai][bj][m][0], v1 = acc[ai][bj][m][1];
                    s += (v0[0] * v0[0] + v0[1] * v0[1]) + (v0[2] * v0[2] + v0[3] * v0[3]) + (v1[0] * v1[0] + v1[1] * v1[1]) + (v1[2] * v1[2] + v1[3] * v1[3]);
                    st8(Y + off, v0, v1); }
                s += __shfl_xor(s, 16); s += __shfl_xor(s, 32);
                if (fq == 0) atomicAdd(ssq + row, s); }
    }
};
}

namespace att {
constexpr int KBUF = 25600, VBUF = 20480, VROW = 320;
constexpr int OFF_K = 0, OFF_V = 2 * KBUF, OFF_POS = OFF_V + 2 * VBUF, OFF_WSF = OFF_POS + 512, OFF_END = OFF_WSF + 8 * 256;
static_assert(OFF_END <= LDS_MAIN, "attention LDS");
constexpr float NEG = -1e30f;
struct Ptrs { const bf16_t *QM, *KM, *VM, *QD, *KD, *VD, *GM, *GD; bf16_t *OM, *OD; const int* pos; const float* gsub; float lam; };
__device__ __forceinline__ int crow(int r, int hi) { return (r & 3) + 8 * (r >> 2) + 4 * hi; }
__device__ __forceinline__ float xmax(float v) { const unsigned u = __float_as_uint(v); auto rr = __builtin_amdgcn_permlane32_swap(u, u, false, false); return fmaxf(__uint_as_float(rr[0]), __uint_as_float(rr[1])); }
__device__ __forceinline__ float xsum(float v) { const unsigned u = __float_as_uint(v); auto rr = __builtin_amdgcn_permlane32_swap(u, u, false, false); return __uint_as_float(rr[0]) + __uint_as_float(rr[1]); }
__device__ __forceinline__ s16x4 vtr(const LAS unsigned char* p) { return __builtin_bit_cast(s16x4, __builtin_amdgcn_ds_read_tr16_b64_v4i16((LAS s16x4*)p)); }
__device__ __forceinline__ bf16x8 pack8(const f32x16& p, int s) {
    u32x4 w; w.x = pk2(p[8 * s + 0], p[8 * s + 1]); w.y = pk2(p[8 * s + 2], p[8 * s + 3]); w.z = pk2(p[8 * s + 4], p[8 * s + 5]); w.w = pk2(p[8 * s + 6], p[8 * s + 7]);
    return __builtin_bit_cast(bf16x8, w);
}

template <bool MLA, bool SAFE> __device__ __forceinline__ int attn_unit(LAS unsigned char* lds, const int b, const int h, const int qb, const Ptrs& P, const int dry) {
    constexpr int ROWS = MLA ? 256 : 128, DK = MLA ? 192 : 64, DKT = MLA ? 192 : 128, KROW = DKT * 2 + 16, CPR = DKT / 8, KCH = (64 * CPR) / 512, ND = DK / 16;
    int tid_ = threadIdx.x; asm volatile("" : "+v"(tid_));
    const int tid = tid_, lane = tid & 63, wid = __builtin_amdgcn_readfirstlane(tid >> 6), r32 = lane & 31, hi = lane >> 5;
    const int rg = MLA ? wid : (wid >> 1), c = MLA ? 0 : (wid & 1);
    const int q0 = qb * ROWS, q0w = q0 + 32 * rg, qabs = q0w + r32;
    const size_t tokb = (size_t)b * SEQ;
    const bf16_t* Kg = MLA ? P.KM + ((size_t)(b * 8 + h) * SEQ) * 192 : P.KD + tokb * 1024 + h * 128;
    constexpr int KLD = MLA ? 192 : 1024;
    const bf16_t* Vg = (MLA ? P.VM : P.VD) + tokb * 1024 + h * 128;
    bf16x8 qf[ND];
    { const bf16_t* Qg = MLA ? P.QM + (tokb + qabs) * 1536 + h * 192 : P.QD + (tokb + qabs) * 1024 + h * 128 + c * 64;
#pragma unroll
      for (int d0 = 0; d0 < ND; ++d0) qf[d0] = *(const bf16x8*)(Qg + d0 * 16 + hi * 8); }
    float posq = 0.f, slope2 = 0.f;
    if (!MLA) { posq = (float)P.pos[tokb + qabs]; slope2 = exp2f(-(float)(h + 1)) * LOG2E; }
#pragma unroll
    for (int d0 = 0; d0 < ND; ++d0) asm volatile("" : "+v"(qf[d0]));
    asm volatile("" : "+v"(posq), "+v"(slope2));
    u32x4 kreg[KCH], vreg[2]; int preg = 0;
    int krow[KCH], kch[KCH], vrow[2], vch[2];
#pragma unroll
    for (int i = 0; i < KCH; ++i) { const int idx = tid + 512 * i; krow[i] = idx / CPR; kch[i] = idx % CPR; }
#pragma unroll
    for (int i = 0; i < 2; ++i) { const int idx = tid + 512 * i; vrow[i] = idx >> 4; vch[i] = idx & 15; }
#define ATT_LOAD(j) do { const int kv0_ = 64 * (j); \
        _Pragma("unroll") for (int i = 0; i < KCH; ++i) kreg[i] = *(const u32x4*)(Kg + (size_t)(kv0_ + krow[i]) * KLD + kch[i] * 8); \
        _Pragma("unroll") for (int i = 0; i < 2; ++i) vreg[i] = *(const u32x4*)(Vg + (size_t)(kv0_ + vrow[i]) * 1024 + vch[i] * 8); \
        if (!MLA) { if (tid < 64) preg = P.pos[tokb + kv0_ + tid]; } } while (0)
#define ATT_WRITE(bf) do { \
        _Pragma("unroll") for (int i = 0; i < KCH; ++i) *(LAS u32x4*)(lds + OFF_K + (bf) * KBUF + krow[i] * KROW + kch[i] * 16) = kreg[i]; \
        _Pragma("unroll") for (int i = 0; i < 2; ++i) *(LAS u32x4*)(lds + OFF_V + (bf) * VBUF + vrow[i] * VROW + vch[i] * 16) = vreg[i]; \
        if (!MLA) { if (tid < 64) *(LAS float*)(lds + OFF_POS + (bf) * 256 + tid * 4) = (float)preg; } } while (0)

    LAS float* wsf = (LAS float*)(lds + OFF_WSF + wid * 256);
    f32x16 o[4];
#pragma unroll
    for (int d = 0; d < 4; ++d)
#pragma unroll
        for (int r = 0; r < 16; ++r) o[d][r] = 0.f;
    float mrun = NEG, lrun = 0.f;
    const int NT = (q0 + ROWS) / 64;
    const int kbase = (r32)*KROW + c * 128 + hi * 16;
    const int vbase = (4 * hi + ((lane & 15) >> 2)) * VROW + (((lane >> 4) & 1) * 16 + (lane & 3) * 4) * 2;

    ATT_LOAD(0);
    __syncthreads();
    ATT_WRITE(0);
    for (int j = 0; j < NT; ++j) {
        const int bf = j & 1;
        if (j + 1 < NT && !(dry & 4)) ATT_LOAD(j + 1);
        __syncthreads();
        const int kv0 = 64 * j;
#pragma unroll 2
        for (int kvh = 0; kvh < 2; ++kvh) {
            const int kvs = kv0 + 32 * kvh;
            if (kvs > q0w + 31 || (dry & 1) || ((dry & 8) && (wid & 4))) break;
            const LAS unsigned char* Kb = lds + OFF_K + bf * KBUF + kbase + kvh * 32 * KROW;
            bf16x8 kf[ND];
#pragma unroll
            for (int d0 = 0; d0 < ND; ++d0) kf[d0] = *(const LAS bf16x8*)(Kb + d0 * 32);
            if (SAFE) __builtin_amdgcn_sched_barrier(0);
            f32x16 p;
#pragma unroll
            for (int r = 0; r < 16; ++r) p[r] = 0.f;
#pragma unroll
            for (int d0 = 0; d0 < ND; ++d0) p = __builtin_amdgcn_mfma_f32_32x32x16_bf16(kf[d0], qf[d0], p, 0, 0, 0);
            if (SAFE) __builtin_amdgcn_sched_barrier(0);
            const LAS unsigned char* Vb = lds + OFF_V + bf * VBUF + vbase + kvh * 32 * VROW;
            s16x4 vlo[8], vhi[8];
#pragma unroll
            for (int s2 = 0; s2 < 2; ++s2)
#pragma unroll
                for (int db = 0; db < 4; ++db) { vlo[s2 * 4 + db] = vtr(Vb + s2 * 16 * VROW + db * 64); vhi[s2 * 4 + db] = vtr(Vb + s2 * 16 * VROW + 8 * VROW + db * 64); }
            if (SAFE) __builtin_amdgcn_sched_barrier(0);
            if (!MLA) {
                const LAS float* pp = (const LAS float*)(lds + OFF_POS + bf * 256) + 32 * kvh + 4 * hi;
#pragma unroll
                for (int g = 0; g < 4; ++g) { const f32x4 a = *(const LAS f32x4*)(pp + 8 * g);
#pragma unroll
                    for (int i = 0; i < 4; ++i) p[4 * g + i] -= slope2 * fabsf(posq - a[i]); }
            }
            if (kvs + 31 > q0w) {
#pragma unroll
                for (int r = 0; r < 16; ++r) { if (kvs + crow(r, hi) > qabs) p[r] = NEG; }
            }
            if (SAFE) {
            float mx;
            { const float m0 = fmaxf(fmaxf(p[0], p[1]), fmaxf(p[2], p[3])), m1 = fmaxf(fmaxf(p[4], p[5]), fmaxf(p[6], p[7]));
              const float m2 = fmaxf(fmaxf(p[8], p[9]), fmaxf(p[10], p[11])), m3 = fmaxf(fmaxf(p[12], p[13]), fmaxf(p[14], p[15]));
              mx = fmaxf(fmaxf(m0, m1), fmaxf(m2, m3)); }
            mx = xmax(mx);
            const float mnew = fmaxf(mrun, mx), alpha = fexp2(mrun - mnew);
            mrun = mnew;
            float rs0 = 0.f, rs1 = 0.f, rs2 = 0.f, rs3 = 0.f;
#pragma unroll
            for (int r = 0; r < 16; r += 4) { p[r] = fexp2(p[r] - mnew); p[r + 1] = fexp2(p[r + 1] - mnew); p[r + 2] = fexp2(p[r + 2] - mnew); p[r + 3] = fexp2(p[r + 3] - mnew);
                rs0 += p[r]; rs1 += p[r + 1]; rs2 += p[r + 2]; rs3 += p[r + 3]; }
            lrun = lrun * alpha + ((rs0 + rs1) + (rs2 + rs3));
            if (__any(alpha != 1.0f)) {
                if (hi == 0) wsf[r32] = alpha;
#pragma unroll
                for (int g = 0; g < 4; ++g) { const f32x4 a4 = *(const LAS f32x4*)(wsf + 8 * g + 4 * hi);
#pragma unroll
                    for (int d = 0; d < 4; ++d)
#pragma unroll
                        for (int i = 0; i < 4; ++i) o[d][4 * g + i] *= a4[i]; }
            }
            } else {
            float rs0 = 0.f, rs1 = 0.f, rs2 = 0.f, rs3 = 0.f;
#pragma unroll
            for (int r = 0; r < 16; r += 4) { p[r] = fexp2(p[r]); p[r + 1] = fexp2(p[r + 1]); p[r + 2] = fexp2(p[r + 2]); p[r + 3] = fexp2(p[r + 3]);
                rs0 += p[r]; rs1 += p[r + 1]; rs2 += p[r + 2]; rs3 += p[r + 3]; }
            lrun += (rs0 + rs1) + (rs2 + rs3);
            }
            if (SAFE) __builtin_amdgcn_sched_barrier(0);
#pragma unroll
            for (int s2 = 0; s2 < 2; ++s2) {
                const bf16x8 pa = pack8(p, s2);
#pragma unroll
                for (int db = 0; db < 4; ++db) {
                    const s16x4 lo = vlo[s2 * 4 + db], hh = vhi[s2 * 4 + db];
                    const bf16x8 vb = (bf16x8){lo[0], lo[1], lo[2], lo[3], hh[0], hh[1], hh[2], hh[3]};
                    o[db] = __builtin_amdgcn_mfma_f32_32x32x16_bf16(pa, vb, o[db], 0, 0, 0);
                }
            }
        }
        if (j + 1 < NT && !(dry & 4)) ATT_WRITE(bf ^ 1);
    }
#undef ATT_LOAD
#undef ATT_WRITE
    int q0e = q0w, r32e = r32, hie = hi; asm volatile("" : "+s"(q0e), "+v"(r32e), "+v"(hie));
    if (dry) { if (dry & 1) asm volatile("" :: "v"(qf[0]), "v"(qf[ND - 1])); else asm volatile("" :: "v"(o[0]), "v"(o[1]), "v"(o[2]), "v"(o[3]), "v"(lrun)); return 0; }
    float lt = xsum(lrun);
    const int bad = SAFE ? 0 : (int)__any(!(lt < 1e30f));
    if (hie == 0) wsf[32 + r32e] = 1.0f / lt;
    f32x4 li[4];
#pragma unroll
    for (int g = 0; g < 4; ++g) li[g] = *(const LAS f32x4*)(wsf + 32 + 8 * g + 4 * hie);
    constexpr int SROW = 272;
    if (MLA) {
        __syncthreads();
        LAS unsigned char* stg = lds + wid * (32 * SROW);
#pragma unroll
        for (int r = 0; r < 16; ++r)
#pragma unroll
            for (int db = 0; db < 4; ++db) *(LAS bf16_t*)(stg + crow(r, hie) * SROW + (32 * db + r32e) * 2) = (bf16_t)f2bf(o[db][r] * li[r >> 2][r & 3]);
        asm volatile("s_waitcnt lgkmcnt(0)" ::: "memory");
#pragma unroll
        for (int i = 0; i < 8; ++i) { const int idx = i * 64 + lane, row = idx >> 4, ch = idx & 15;
            const u32x4 ov = *(const LAS u32x4*)(stg + row * SROW + ch * 16);
            const size_t off = (tokb + q0e + row) * 1024 + h * 128 + ch * 8, offo = (tokb + q0e + row) * 2048 + h * 128 + ch * 8;
            const u32x4 g = *(const u32x4*)(P.GM + off);
            u32x4 w; w.x = pk2(bflo(ov.x) * bflo(g.x), bfhi(ov.x) * bfhi(g.x)); w.y = pk2(bflo(ov.y) * bflo(g.y), bfhi(ov.y) * bfhi(g.y));
            w.z = pk2(bflo(ov.z) * bflo(g.z), bfhi(ov.z) * bfhi(g.z)); w.w = pk2(bflo(ov.w) * bflo(g.w), bfhi(ov.w) * bfhi(g.w));
            *(u32x4*)(P.OM + offo) = w; }
    } else {
        LAS float* comb = (LAS float*)lds;
        __syncthreads();
        if (c == 1) {
#pragma unroll
            for (int r = 0; r < 16; ++r)
#pragma unroll
                for (int db = 0; db < 4; ++db) comb[((rg * 16 + r) * 2 + hie) * 128 + db * 32 + r32e] = o[db][r] * li[r >> 2][r & 3];
        }
        __syncthreads();
        if (c == 0) {
            float gs[4];
#pragma unroll
            for (int db = 0; db < 4; ++db) gs[db] = P.gsub[32 * db + r32e] * (1.0f - LAMBDA_INIT);
#pragma unroll
            for (int r = 0; r < 16; ++r)
#pragma unroll
                for (int db = 0; db < 4; ++db) o[db][r] = o[db][r] * li[r >> 2][r & 3] - P.lam * comb[((rg * 16 + r) * 2 + hie) * 128 + db * 32 + r32e];
            asm volatile("s_waitcnt lgkmcnt(0)" ::: "memory");
            LAS unsigned char* stg = lds + rg * 16384;
#pragma unroll
            for (int r = 0; r < 16; ++r) { float ss = 0.f;
#pragma unroll
                for (int db = 0; db < 4; ++db) ss += o[db][r] * o[db][r];
                ss += __shfl_xor(ss, 1); ss += __shfl_xor(ss, 2); ss += __shfl_xor(ss, 4); ss += __shfl_xor(ss, 8); ss += __shfl_xor(ss, 16);
                const float rstd = rsqrtf(ss * (1.0f / 128.0f) + EPS);
#pragma unroll
                for (int db = 0; db < 4; ++db) *(LAS bf16_t*)(stg + crow(r, hie) * SROW + (32 * db + r32e) * 2) = (bf16_t)f2bf(o[db][r] * rstd * gs[db]); }
            asm volatile("s_waitcnt lgkmcnt(0)" ::: "memory");
#pragma unroll
            for (int i = 0; i < 8; ++i) { const int idx = i * 64 + lane, row = idx >> 4, ch = idx & 15;
                const u32x4 ov = *(const LAS u32x4*)(stg + row * SROW + ch * 16);
                const size_t off = (tokb + q0e + row) * 1024 + h * 128 + ch * 8, offo = (tokb + q0e + row) * 2048 + 1024 + h * 128 + ch * 8;
                const u32x4 g = *(const u32x4*)(P.GD + off);
                u32x4 w; w.x = pk2(bflo(ov.x) * bflo(g.x), bfhi(ov.x) * bfhi(g.x)); w.y = pk2(bflo(ov.y) * bflo(g.y), bfhi(ov.y) * bfhi(g.y));
                w.z = pk2(bflo(ov.z) * bflo(g.z), bfhi(ov.z) * bfhi(g.z)); w.w = pk2(bflo(ov.w) * bflo(g.w), bfhi(ov.w) * bfhi(g.w));
                *(u32x4*)(P.OD + offo) = w; }
        }
    }
    return bad;
}
}

#define XB_TMO      128
#define XB_XCNT(j)  (256  + 64 * (j))
#define XB_XSUB(j)  (1280 + 64 * (j))
#define XB_XGEN(j)  (2304 + 64 * (j))
#define XB_TOP      3328
#define XB_TOPGEN   3392
#define XCD_BAR_WORDS 3456
#define XB_SPIN_CAP (1u << 18)

__device__ __forceinline__ unsigned xb_ld(unsigned* p)              { return __hip_atomic_load(p, __ATOMIC_RELAXED, __HIP_MEMORY_SCOPE_AGENT); }
__device__ __forceinline__ unsigned xb_add(unsigned* p, unsigned v) { return __hip_atomic_fetch_add(p, v, __ATOMIC_RELAXED, __HIP_MEMORY_SCOPE_AGENT); }
__device__ __forceinline__ unsigned xb_xcc_id() { return (unsigned)__builtin_amdgcn_s_getreg((3 << 11) | 20) & 0xFu; }
#define XB_SPIN(cond, bar) do { unsigned _sp = 0; while (cond) { __builtin_amdgcn_s_sleep(1); \
    if ((++_sp & 255u) == 0u) { if (xb_ld(&(bar)[XB_TMO])) break; if (_sp > XB_SPIN_CAP) { atomicAdd(&(bar)[XB_TMO], 1u); break; } } } } while (0)

struct XcdBarrier {
    unsigned* bar; unsigned x;
    volatile LAS unsigned* st;
};

__device__ __forceinline__ XcdBarrier xcd_barrier_post(unsigned* bar, volatile LAS unsigned* st) {
    XcdBarrier b; b.bar = bar; b.x = xb_xcc_id(); b.st = st;
    if (threadIdx.x == 0) (void)xb_add(&bar[XB_XCNT(b.x)], 1u);
    return b;
}
__device__ __forceinline__ void xcd_barrier_complete(unsigned* bar, unsigned x, unsigned& nloc, unsigned& nx) {
    const unsigned G = gridDim.x * gridDim.y * gridDim.z;
    unsigned sum, cnt, mine, sp = 0u;
    for (;;) {
        sum = 0u; cnt = 0u; mine = 0u;
#pragma unroll
        for (unsigned j = 0; j < 16; ++j) { const unsigned c = xb_ld(&bar[XB_XCNT(j)]); sum += c; cnt += (c > 0u) ? 1u : 0u; mine = (j == x) ? c : mine; }
        if (sum == G) break;
        __builtin_amdgcn_s_sleep(1);
        if ((++sp & 255u) == 0u) { if (xb_ld(&bar[XB_TMO])) break; if (sp > XB_SPIN_CAP) { atomicAdd(&bar[XB_TMO], 1u); break; } }
    }
    nloc = mine > 0u ? mine : 1u; nx = cnt > 0u ? cnt : 1u;
}

__device__ __forceinline__ void xcd_barrier(const XcdBarrier& b) {
    asm volatile("s_waitcnt vmcnt(0)" ::: "memory");
    __syncthreads();
    if (threadIdx.x == 0) {
        unsigned* bar = b.bar;
        __builtin_amdgcn_s_waitcnt(0);
        unsigned nloc = b.st[0], nx = b.st[1];
        if (nloc == 0u) { xcd_barrier_complete(bar, b.x, nloc, nx); b.st[0] = nloc; b.st[1] = nx; }
        const unsigned old = xb_add(&bar[XB_XSUB(b.x)], 1u);
        const unsigned gen = old / nloc;
        if (old + 1u == (gen + 1u) * nloc) {
            __builtin_amdgcn_fence(__ATOMIC_RELEASE, "agent");
            asm volatile("s_waitcnt vmcnt(0)" ::: "memory");
            const unsigned og = xb_add(&bar[XB_TOP], 1u);
            const unsigned tg = og / nx;
            if (og + 1u == (tg + 1u) * nx) xb_add(&bar[XB_TOPGEN], 1u);
            else XB_SPIN(xb_ld(&bar[XB_TOPGEN]) == tg, bar);
            __builtin_amdgcn_fence(__ATOMIC_ACQUIRE, "agent");
            xb_add(&bar[XB_XGEN(b.x)], 1u);
            asm volatile("s_waitcnt vmcnt(0)" ::: "memory");
        } else {
            XB_SPIN(xb_ld(&bar[XB_XGEN(b.x)]) == gen, bar);
            __builtin_amdgcn_fence(__ATOMIC_ACQUIRE, "agent");
            asm volatile("s_waitcnt vmcnt(0)" ::: "memory");
        }
    }
    __syncthreads();
}

struct TrDesc { const float* W; bf16_t* WT; const float* gk; int K, N, k0, n0, mode, kd; };
__device__ __forceinline__ void tr_load(const TrDesc& d, float (&vv)[32], int lane) {
    int sc = d.n0 + (lane & 31); if (d.mode == 1) sc = vsrc_in(sc);
    const float* src = d.W + (size_t)(d.k0 + (lane >> 5)) * d.N + (sc < 0 ? 0 : sc);
    const size_t step = (size_t)2 * d.N;
#pragma unroll
    for (int i = 0; i < 32; ++i) { const float v = src[i * step]; vv[i] = (sc < 0) ? 0.f : v; }
}
__device__ __forceinline__ void tr_store(const TrDesc& d, const float (&vv)[32], LAS float* scr, int lane) {
#pragma unroll
    for (int i = 0; i < 32; ++i) { const int kk = 2 * i + (lane >> 5); float v = vv[i];
        if (d.mode == 2) v *= d.gk[d.k0 + kk];
        scr[kk * 33 + (lane & 31)] = v; }
    asm volatile("s_waitcnt lgkmcnt(0)" ::: "memory");
    const int c = lane & 7;
#pragma unroll
    for (int j = 0; j < 4; ++j) { const int n = (lane >> 3) + 8 * j; const LAS float* sp = scr + (8 * c) * 33 + n;
        u32x4 o; o.x = pk2(sp[0 * 33], sp[1 * 33]); o.y = pk2(sp[2 * 33], sp[3 * 33]); o.z = pk2(sp[4 * 33], sp[5 * 33]); o.w = pk2(sp[6 * 33], sp[7 * 33]);
        *(u32x4*)(d.WT + (size_t)(d.n0 + n) * d.K + d.kd + d.k0 + 8 * c) = o; }
    asm volatile("s_waitcnt lgkmcnt(0)" ::: "memory");
}

struct Args {
    const float *x, *c; const int* pos; const float *w_ada, *b_ada, *g_pre, *w_in, *g_kv, *w_ukv, *lq1, *lk1, *lq2, *lk2, *g_subln, *w_o_mla, *w_o_diff, *w_out, *g_post;
    float* out; unsigned char* ws;
};

__global__ void __launch_bounds__(512, 2) fwd_kernel(Args A) {
    extern __shared__ __attribute__((aligned(16))) unsigned char lds_raw[];
    LAS unsigned char* lds = (LAS unsigned char*)lds_raw;
    cg::grid_group grid = cg::this_grid();
    if (A.ws == nullptr) grid.sync();
    { volatile LAS unsigned* st0 = (volatile LAS unsigned*)(lds + LDS_MISC + 64); if (threadIdx.x < 2) st0[threadIdx.x] = 0u; }
    __syncthreads();
    const XcdBarrier xbar = xcd_barrier_post((unsigned*)(A.ws + WS_CTL) + CTL_BAR, (volatile LAS unsigned*)(lds + LDS_MISC + 64));
#if PROBE_DUP == 9
#define GRID_SYNC() do { xcd_barrier(xbar); xcd_barrier(xbar); } while (0)
#else
#define GRID_SYNC() xcd_barrier(xbar)
#endif
    const int G = gridDim.x, NGW = G * 8;
#define PHASE_IDS() int tid = threadIdx.x; asm volatile("" : "+v"(tid)); const int lane = tid & 63, wave = __builtin_amdgcn_readfirstlane(tid >> 6), gw = blockIdx.x * 8 + wave; (void)lane; (void)gw
    unsigned char* ws = A.ws;
    float* ctl = (float*)(ws + WS_CTL);
    float* ssqc = ctl + CTL_SSQC; float* ssqy = ctl + CTL_SSQY; float* ada = ctl + CTL_ADA; unsigned* queue = (unsigned*)(ctl + CTL_QUEUE);
    float* ropec = (float*)(ws + WS_ROPE); float* ropes = ropec + MTOK * 32;
    bf16_t *WUKV = (bf16_t*)(ws + WS_WUKV), *WOM = (bf16_t*)(ws + WS_WOM), *WOD = (bf16_t*)(ws + WS_WOD), *WOUT = (bf16_t*)(ws + WS_WOUT), *WIN = (bf16_t*)(ws + WS_WIN);
    bf16_t *H = (bf16_t*)(ws + WS_H), *MG = (bf16_t*)(ws + WS_H);
    bf16_t *QM = (bf16_t*)(ws + WS_QM), *CKV = (bf16_t*)(ws + WS_CKV), *KM = (bf16_t*)(ws + WS_KM), *VM = (bf16_t*)(ws + WS_VM);
    bf16_t *QD = (bf16_t*)(ws + WS_QD), *KD = (bf16_t*)(ws + WS_KD), *VD = (bf16_t*)(ws + WS_VD), *GM = (bf16_t*)(ws + WS_GM), *GD = (bf16_t*)(ws + WS_GD);
    bf16_t *SM = (bf16_t*)(ws + WS_SM), *SD = (bf16_t*)(ws + WS_SD), *OM = (bf16_t*)(ws + WS_OA), *OD = (bf16_t*)(ws + WS_OA);
    bf16_t* Y = (bf16_t*)(ws + WS_Y);

    {
        PHASE_IDS();
#if PROBE_DUP == 0
#define P0SKIP(rep) ((rep) ? PROBE_DRY : 0)
        for (int rep = 0; rep < 2; ++rep) { float* ada_ = rep ? ctl + 65536 : ada;
#else
#define P0SKIP(rep) 0
        { float* ada_ = ada; const int rep = 0; (void)rep;
#endif
        LAS float* scr = (LAS float*)(lds + wave * 8448);
        constexpr int I_IN = 32 * (INWP / 32), I_UKV = 8 * 64, I_OM = 16 * 64, I_OD = 16 * 64, I_OUT = 32 * 64, I_ADA = 96 * 32;
        constexpr int NTR = I_IN + I_UKV + I_OM + I_OD + I_OUT;
        if (!(P0SKIP(rep) & 1))
        for (int r = gw; r < I_ADA; r += NGW) {
            const int cb = r % 96, kc = r / 96, j = cb * 64 + lane, k0 = kc * 64; float a0 = 0.f, a1 = 0.f;
#pragma unroll
            for (int k = 0; k < 64; ++k) { const float w = A.w_ada[(size_t)(k0 + k) * 6144 + j]; a0 += A.c[k0 + k] * w; a1 += A.c[DM + k0 + k] * w; }
            atomicAdd(ada_ + j, a0); atomicAdd(ada_ + 6144 + j, a1);
        }
#define TR_DECODE(d, it_) do { int r_ = (it_); \
            if (r_ < I_IN) { d.W = A.w_in; d.WT = WIN; d.gk = nullptr; d.kd = 0; d.K = DM; d.N = INW; d.mode = 1; d.k0 = 64 * (r_ % 32); d.n0 = 32 * (r_ / 32); } \
            else if ((r_ -= I_IN) < I_UKV) { d.W = A.w_ukv; d.WT = WUKV; d.gk = A.g_kv; d.kd = 0; d.K = 512; d.N = 2048; d.mode = 2; d.k0 = 64 * (r_ % 8); d.n0 = 32 * (r_ / 8); } \
            else if ((r_ -= I_UKV) < I_OM) { d.W = A.w_o_mla; d.WT = WOM; d.gk = nullptr; d.kd = 0; d.K = 2048; d.N = 2048; d.mode = 0; d.k0 = 64 * (r_ % 16); d.n0 = 32 * (r_ / 16); } \
            else if ((r_ -= I_OM) < I_OD) { d.W = A.w_o_diff; d.WT = WOM; d.gk = nullptr; d.kd = 1024; d.K = 2048; d.N = 2048; d.mode = 0; d.k0 = 64 * (r_ % 16); d.n0 = 32 * (r_ / 16); } \
            else { r_ -= I_OD; d.W = A.w_out; d.WT = WOUT; d.gk = nullptr; d.kd = 0; d.K = 2048; d.N = 2048; d.mode = 0; d.k0 = 64 * (r_ % 32); d.n0 = 32 * (r_ / 32); } } while (0)
        if (!(P0SKIP(rep) & 2)) {
            float va[32], vb[32]; TrDesc da, db; int it = gw;
            if (it < NTR) { TR_DECODE(da, it); tr_load(da, va, lane); }
            while (it < NTR) {
                const int i1 = it + NGW, i2 = it + 2 * NGW;
                if (i1 < NTR) { TR_DECODE(db, i1); tr_load(db, vb, lane); }
                tr_store(da, va, scr, lane);
                if (i1 >= NTR) break;
                if (i2 < NTR) { TR_DECODE(da, i2); tr_load(da, va, lane); }
                tr_store(db, vb, scr, lane);
                it = i2;
            }
        }
#undef TR_DECODE
        if (!(P0SKIP(rep) & 4)) {
            LAS float* invt = (LAS float*)(lds + 8 * 8448);
            __syncthreads();
            if (tid < 32) invt[tid] = powf(10000.0f, -(float)tid / 32.0f);
            __syncthreads();
            for (int e = blockIdx.x * 512 + tid; e < MTOK * 32; e += G * 512) {
                const int t = e >> 5, i = e & 31;
                const float ang = (float)A.pos[t] * invt[i];
                const float k = rintf(ang * 0.6366197723675814f);
                float r = fmaf(-k, 1.5703125f, ang); r = fmaf(-k, 4.837512969970703125e-4f, r); r = fmaf(-k, 7.54978995489188216e-8f, r);
                const float r2 = r * r;
                const float sn = r + r * r2 * (-1.6666667163e-1f + r2 * (8.3333337680e-3f + r2 * (-1.9841270114e-4f + r2 * 2.7557314297e-6f)));
                const float cs = 1.0f + r2 * (-0.5f + r2 * (4.1666667908e-2f + r2 * (-1.3888889225e-3f + r2 * (2.4801587642e-5f + r2 * -2.7557314297e-7f))));
                const int qd = ((int)k) & 3;
                const float s_ = (qd == 0) ? sn : (qd == 1) ? cs : (qd == 2) ? -sn : -cs;
                const float c_ = (qd == 0) ? cs : (qd == 1) ? -sn : (qd == 2) ? -cs : sn;
                ropec[e] = c_; ropes[e] = s_;
            }
        }
        }
    }
    GRID_SYNC();

    {
        PHASE_IDS();
        LAS float* mA = (LAS float*)lds;
        LAS float* mB = mA + 2 * DM;
        for (int e = tid; e < 2 * DM; e += 512) { const int b = e >> 11, n = e & 2047;
            mA[e] = A.g_pre[n] * (1.0f + ada[b * 6144 + 2048 + n] + A.b_ada[2048 + n]); mB[e] = ada[b * 6144 + n] + A.b_ada[n]; }
        __syncthreads();
        for (int m = gw; m < MTOK; m += NGW) {
            const int b = m >> 12; const f32x4* xr = (const f32x4*)(A.x + (size_t)m * DM) + lane;
            f32x4 v[8]; float s = 0.f;
#pragma unroll
            for (int j = 0; j < 8; ++j) { v[j] = xr[64 * j]; s += (v[j][0] * v[j][0] + v[j][1] * v[j][1]) + (v[j][2] * v[j][2] + v[j][3] * v[j][3]); }
            const float rstd = rsqrtf(wave_sum(s) * (1.0f / DM) + EPS);
            u32x2* o8 = (u32x2*)(H + (size_t)m * DM) + lane;
#pragma unroll
            for (int j = 0; j < 8; ++j) { const int n = b * DM + 256 * j + 4 * lane; const f32x4 a = *(const LAS f32x4*)(mA + n), sh = *(const LAS f32x4*)(mB + n);
                u32x2 w; w.x = pk2(v[j][0] * rstd * a[0] + sh[0], v[j][1] * rstd * a[1] + sh[1]); w.y = pk2(v[j][2] * rstd * a[2] + sh[2], v[j][3] * rstd * a[3] + sh[3]);
                o8[64 * j] = w; }
        }
        __syncthreads();
    }
    GRID_SYNC();

#ifndef SKIP_P2
    {
        pg8::Gemm g{H, WIN, MTOK, INWP, DM}; pg8::StaticOrder S; S.init(MTOK, INWP, G, (int)blockIdx.x);
        epi::EpiProj E{QM, CKV, QD, KD, VD, GM, GD, SM, SD, KM, ssqc, ropec, ropes};
        pg8::gemm_phase<epi::EpiProj, pg8::StaticOrder, true, true>(lds, g, S, E);
#if PROBE_DUP == 2
        __syncthreads();
        epi::EpiProj E2{QM, CKV, QD, KD, VD, GM, GD, SM, SD, KM, ctl + 65536, ropec, ropes};
        pg8::gemm_phase<epi::EpiProj, pg8::StaticOrder, true, true>(lds, g, S, E2);
#endif
    }
#endif
    GRID_SYNC();

    {
        pg8::Gemm g{CKV, WUKV, MTOK, 2048, 512}; pg8::StaticOrder S; S.init(MTOK, 2048, G, (int)blockIdx.x);
        epi::EpiUp E{KM, VM, ssqc};
        pg8::gemm_phase<epi::EpiUp, pg8::StaticOrder, true, true>(lds, g, S, E);
    }
    GRID_SYNC();

#ifndef SKIP_P4
    {
        PHASE_IDS();
        att::Ptrs P; P.QM = QM; P.KM = KM; P.VM = VM; P.QD = QD; P.KD = KD; P.VD = VD; P.GM = GM; P.GD = GD; P.OM = OM; P.OD = OD; P.pos = A.pos; P.gsub = A.g_subln;
        { const float s1 = wave_sum(A.lq1[lane] * A.lk1[lane]), s2 = wave_sum(A.lq2[lane] * A.lk2[lane]); P.lam = expf(s1) - expf(s2) + LAMBDA_INIT; }
        LAS unsigned* qslot = (LAS unsigned*)(lds + LDS_MISC);
#define ATT_RUN(M_, b_, h_, qb_) do { const int bad_ = att::attn_unit<M_, false>(lds, (b_), (h_), (qb_), P, rep ? PROBE_DRY : 0); \
            if (__syncthreads_or(bad_)) (void)att::attn_unit<M_, true>(lds, (b_), (h_), (qb_), P, rep ? PROBE_DRY : 0); } while (0)
#if PROBE_DUP == 4
        for (int rep = 0; rep < 2; ++rep)
#else
        const int rep = 0;
#endif
        if (STATIC_PLAN && G == 256) {
            const int x = blockIdx.x & 7, k = blockIdx.x >> 3;
            if (k < 16) { const int bh = 2 * x + (k >> 3), i = k & 7;
                ATT_RUN(true, bh >> 3, bh & 7, 15 - i);
                ATT_RUN(true, bh >> 3, bh & 7, i);
            } else { const int j = k - 16;
#pragma unroll 1
                for (int u = 0; u < 4; ++u) { const int bh = 2 * x + (u & 1), qb = (u < 2) ? 31 - j : j;
                    ATT_RUN(false, bh >> 3, bh & 7, qb); }
            }
        } else
        for (;;) {
            __syncthreads();
            if (tid == 0) *qslot = atomicAdd(queue + rep, 1u);
            __syncthreads();
            int rem = (int)*qslot;
            if (rem >= 768) break;
            int type = -1, qb = 0;
            for (int cv = 160; cv >= 3; --cv) {
                if (cv % 10 == 0) { if (rem < 16) { type = 0; qb = cv / 10 - 1; break; } rem -= 16; }
                if (cv % 3 == 0 && cv <= 96) { if (rem < 16) { type = 1; qb = cv / 3 - 1; break; } rem -= 16; }
            }
            const int b = rem >> 3, h = rem & 7;
            if (type == 0) ATT_RUN(true, b, h, qb);
            else ATT_RUN(false, b, h, qb);
        }
        __syncthreads();
    }
#endif
    GRID_SYNC();

    {
        pg8::StaticOrder S; S.init(MTOK, DM, G, (int)blockIdx.x);
        pg8::Gemm g{OM, WOM, MTOK, DM, 2048}; epi::EpiMerge E{SD, MG}; epi::HookMerge Hk{SM, SD};
        pg8::gemm_phase<epi::EpiMerge, pg8::StaticOrder, true, true, epi::HookMerge>(lds, g, S, E, Hk);
    }
    GRID_SYNC();

    {
        pg8::Gemm g{MG, WOUT, MTOK, DM, DM}; pg8::StaticOrder S; S.init(MTOK, DM, G, (int)blockIdx.x);
        epi::EpiOut E{Y, ssqy};
        pg8::gemm_phase<epi::EpiOut, pg8::StaticOrder, true, true>(lds, g, S, E);
    }
    GRID_SYNC();

    {
        PHASE_IDS();
        LAS float* gg = (LAS float*)lds;
        for (int e = tid; e < 2 * DM; e += 512) { const int b = e >> 11, n = e & 2047; gg[e] = (ada[b * 6144 + 4096 + n] + A.b_ada[4096 + n]) * A.g_post[n]; }
        __syncthreads();
        for (int m = gw; m < MTOK; m += NGW) {
            const int b = m >> 12; const float rstd = rsqrtf(ssqy[m] * (1.0f / DM) + EPS);
            const f32x4* xr = (const f32x4*)(A.x + (size_t)m * DM) + lane; const u32x2* yr = (const u32x2*)(Y + (size_t)m * DM) + lane; f32x4* orow = (f32x4*)(A.out + (size_t)m * DM) + lane;
#pragma unroll
            for (int j = 0; j < 8; ++j) { const f32x4 g4 = *(const LAS f32x4*)(gg + b * DM + 256 * j + 4 * lane); const u32x2 yy = yr[64 * j]; const f32x4 y4 = {bflo(yy.x), bfhi(yy.x), bflo(yy.y), bfhi(yy.y)};
                orow[64 * j] = xr[64 * j] + y4 * g4 * rstd; }
        }
    }
}

extern "C" void kernel_launch(void* const* d_in, const int* in_sizes, int n_in, void* d_out, int out_size, void* d_ws, size_t ws_size, hipStream_t stream) {
    static int grid_blocks = 0;
    if (grid_blocks == 0) {
        if (n_in != 18 || in_sizes[0] != MTOK * DM || out_size != MTOK * DM || ws_size < WS_END) { fprintf(stderr, "kernel_launch: unexpected shapes (n_in %d, in0 %d, out %d, ws %zu)\n", n_in, n_in > 0 ? in_sizes[0] : -1, out_size, ws_size); grid_blocks = -1; return; }
        int dev = 0, cus = 0, per_cu = 0;
        (void)hipGetDevice(&dev); (void)hipDeviceGetAttribute(&cus, hipDeviceAttributeMultiprocessorCount, dev);
        if (hipFuncSetAttribute((const void*)fwd_kernel, hipFuncAttributeMaxDynamicSharedMemorySize, LDS_BYTES) != hipSuccess) { fprintf(stderr, "kernel_launch: hipFuncSetAttribute failed\n"); grid_blocks = -1; return; }
        if (hipOccupancyMaxActiveBlocksPerMultiprocessor(&per_cu, (const void*)fwd_kernel, 512, LDS_BYTES) != hipSuccess || per_cu < 1) { fprintf(stderr, "kernel_launch: occupancy query says %d\n", per_cu); per_cu = 1; }
        (void)hipGetLastError();
        grid_blocks = cus;
    }
    if (grid_blocks < 0) return;
    (void)hipMemsetAsync((char*)d_ws + WS_CTL, 0, CTL_BYTES, stream);
    Args a{};
    a.x = (const float*)d_in[0]; a.c = (const float*)d_in[1]; a.pos = (const int*)d_in[2]; a.w_ada = (const float*)d_in[3]; a.b_ada = (const float*)d_in[4]; a.g_pre = (const float*)d_in[5];
    a.w_in = (const float*)d_in[6]; a.g_kv = (const float*)d_in[7]; a.w_ukv = (const float*)d_in[8]; a.lq1 = (const float*)d_in[9]; a.lk1 = (const float*)d_in[10]; a.lq2 = (const float*)d_in[11]; a.lk2 = (const float*)d_in[12];
    a.g_subln = (const float*)d_in[13]; a.w_o_mla = (const float*)d_in[14]; a.w_o_diff = (const float*)d_in[15]; a.w_out = (const float*)d_in[16]; a.g_post = (const float*)d_in[17];
    a.out = (float*)d_out; a.ws = (unsigned char*)d_ws;
    void* args[] = {&a};
    hipError_t e = hipLaunchCooperativeKernel((const void*)fwd_kernel, dim3(grid_blocks), dim3(512), args, LDS_BYTES, stream);
    if (e != hipSuccess) fprintf(stderr, "cooperative launch failed: %s (grid %d)\n", hipGetErrorString(e), grid_blocks);
}
```

```cpp
#include <hip/hip_runtime.h>
#include <hip/hip_cooperative_groups.h>
#include <cstdio>
#include <cstdint>
namespace pg8 {
#define PG8_LAS __attribute__((address_space(3)))
typedef unsigned short bf16_t;
typedef short bf16x8 __attribute__((ext_vector_type(8)));
typedef float f32x4 __attribute__((ext_vector_type(4)));
typedef unsigned u32x4 __attribute__((ext_vector_type(4)));
constexpr int BM = 256, BK = 64, HALF = 128, HTB = HALF * BK * 2  , STAGE_BYTES = 8 * HTB, NXCD = 8, WGM = 8;

__host__ __device__ __forceinline__ int lds_byte(int r, int c) { const int st = (r >> 4) * 2 + (c >> 5), rr = r & 15, cc = c & 31, ob = rr * 64 + cc * 2; return st * 1024 + (ob ^ (((ob >> 9) & 1) << 5)); }
__host__ __device__ __forceinline__ void stage_rc(int b, int& R, int& C) { const int st = b / 1024, sb = b % 1024, swz = sb ^ (((sb >> 9) & 1) << 5); R = (st >> 1) * 16 + swz / 64; C = (st & 1) * 32 + (swz % 64) / 2; }
__host__ __device__ __forceinline__ int perm32(int rho) { const int n = rho >> 4, i = rho & 15; return 8 * (i >> 2) + 4 * n + (i & 3); }

struct Unit { int pm, pn; };
struct Gemm { const bf16_t* A; const bf16_t* Bt; int M, N, K; };

struct StaticOrder {
    int nM, nN, nwg, G, c;
    __host__ __device__ void init(int M, int N, int G_, int c_) { nM = M / BM; nN = N / BM; nwg = nM * nN; G = G_; c = c_; }
    __host__ __device__ bool next(int i, Unit& u) const {
        const long L = (long)i * G + c; if (L >= nwg) return false;
        int wgid = (int)L; { const int q = nwg / NXCD, r = nwg % NXCD, xcd = wgid % NXCD, off = wgid / NXCD; wgid = (xcd < r ? xcd * (q + 1) : r * (q + 1) + (xcd - r) * q) + off; }
        const int nig = WGM * nN, gid = wgid / nig, fm = gid * WGM, gsz = (nM - fm) < WGM ? (nM - fm) : WGM;
        u.pm = fm + ((wgid % nig) % gsz); u.pn = (wgid % nig) / gsz; return true;
    }
    __device__ __forceinline__ void a_ready(const Unit&) const {}
    __device__ __forceinline__ void done(const Unit&) const {}
};

__device__ __forceinline__ unsigned cvt_pk_bf16(float lo, float hi) { unsigned r; asm volatile("v_cvt_pk_bf16_f32 %0, %1, %2" : "=v"(r) : "v"(lo), "v"(hi)); return r; }
struct NoHook { static constexpr bool ON = false; static constexpr int T = 0; template <class A_> __device__ __forceinline__ void mid(A_&, const Unit&, int, int, int, int) const {} };
template <class Epi, class Sched, bool ALIGN_EPI = false, bool SP2 = false, class Hook = NoHook>
__device__ __forceinline__ void gemm_phase(PG8_LAS unsigned char* lds, const Gemm g, const Sched& S, const Epi& E, const Hook& H = Hook()) {
    int tid_ = threadIdx.x; asm volatile("" : "+v"(tid_));
    const int tid = tid_, wid = __builtin_amdgcn_readfirstlane(tid >> 6), lane = tid & 63, wr = wid >> 2, wc = wid & 3, fr = lane & 15, fq = lane >> 4;
    const int K = g.K, nt = K / BK;
    unsigned voffA[2], voffB[2];
#pragma unroll
    for (int i = 0; i < 2; ++i) { int R, C; stage_rc(tid * 16 + i * 8192, R, C); const int Rb = Epi::PERM ? ((R & ~31) + perm32(R & 31)) : R;
        voffA[i] = (unsigned)(R * K + C) * 2u; voffB[i] = (unsigned)(Rb * K + C) * 2u; }
    const size_t kstep = (size_t)(BK * 2);
    const size_t hstep = (size_t)HALF * K * 2;
    const size_t tstep = 2 * hstep;
    const unsigned ldsw = (unsigned)wid * 1024u;
    const int aoff = lds_byte(wr * 64 + fr, fq * 8), boff = lds_byte(wc * 32 + fr, fq * 8);
#define PG8_SA(b, h) (((b) * 2 + (h)) * HTB)
#define PG8_SB(b, h) ((4 + (b) * 2 + (h)) * HTB)
#define PG8_STAGE(bufoff, gbase, voff) do { _Pragma("unroll") for (int _i = 0; _i < 2; ++_i) \
        __builtin_amdgcn_global_load_lds((const unsigned*)((const char*)(gbase) + (voff)[_i]), (PG8_LAS unsigned*)(lds + (bufoff) + ldsw + _i * 8192), 16, 0, 0); } while (0)
#define PG8_LDA(dst, b, h) do { _Pragma("unroll") for (int m = 0; m < 4; ++m) _Pragma("unroll") for (int k = 0; k < 2; ++k) dst[m][k] = *(const PG8_LAS bf16x8*)(lds + PG8_SA(b, h) + aoff + m * 2048 + k * 1024); } while (0)
#define PG8_LDB(dst, b, h) do { _Pragma("unroll") for (int n = 0; n < 2; ++n) _Pragma("unroll") for (int k = 0; k < 2; ++k) dst[n][k] = *(const PG8_LAS bf16x8*)(lds + PG8_SB(b, h) + boff + n * 2048 + k * 1024); } while (0)
#define PG8_MMA(ai, bj, At, Bt) do { __builtin_amdgcn_s_setprio(1); _Pragma("unroll") for (int m = 0; m < 4; ++m) _Pragma("unroll") for (int n = 0; n < 2; ++n) _Pragma("unroll") for (int k = 0; k < 2; ++k) \
        acc[ai][bj][m][n] = __builtin_amdgcn_mfma_f32_16x16x32_bf16(Bt[n][k], At[m][k], acc[ai][bj][m][n], 0, 0, 0); __builtin_amdgcn_s_setprio(0); } while (0)
#define PG8_WAIT_V(n) asm volatile("s_waitcnt vmcnt(" #n ")" ::: "memory")
#define PG8_WAIT_L(n) asm volatile("s_waitcnt lgkmcnt(" #n ")" ::: "memory")
#define PG8_BAR __builtin_amdgcn_s_barrier()
#define PG8_SCHED __builtin_amdgcn_sched_barrier(0)
    Unit cur, nxt; int ui = 0;
    if (!S.next(0, cur)) return;
    f32x4 acc[2][2][4][2];
#pragma unroll
    for (int a = 0; a < 2; ++a)
#pragma unroll
        for (int b = 0; b < 2; ++b)
#pragma unroll
            for (int m = 0; m < 4; ++m)
#pragma unroll
                for (int n = 0; n < 2; ++n) acc[a][b][m][n] = (f32x4){0.f, 0.f, 0.f, 0.f};
    bf16x8 At[4][2], B0[2][2], B1[2][2];
    const char* cA = (const char*)g.A + (size_t)cur.pm * tstep; const char* cB = (const char*)g.Bt + (size_t)cur.pn * tstep;
    S.a_ready(cur);
    if constexpr (SP2) {
        PG8_STAGE(PG8_SB(0, 0), cB, voffB); PG8_STAGE(PG8_SB(0, 1), cB + hstep, voffB); PG8_STAGE(PG8_SA(0, 0), cA, voffA); PG8_STAGE(PG8_SA(0, 1), cA + hstep, voffA);
        if (wr == 1) PG8_BAR;
        PG8_WAIT_V(2); PG8_BAR;
        PG8_STAGE(PG8_SB(1, 0), cB + kstep, voffB); PG8_STAGE(PG8_SA(1, 0), cA + kstep, voffA); PG8_STAGE(PG8_SB(1, 1), cB + hstep + kstep, voffB);
        PG8_WAIT_V(6); PG8_BAR;
    } else {
        PG8_STAGE(PG8_SB(0, 0), cB, voffB); PG8_STAGE(PG8_SA(0, 0), cA, voffA); PG8_STAGE(PG8_SB(0, 1), cB + hstep, voffB); PG8_STAGE(PG8_SA(0, 1), cA + hstep, voffA);
        if (wr == 1) PG8_BAR;
        PG8_WAIT_V(4); PG8_BAR;
        PG8_STAGE(PG8_SB(1, 0), cB + kstep, voffB); PG8_STAGE(PG8_SA(1, 0), cA + kstep, voffA); PG8_STAGE(PG8_SB(1, 1), cB + hstep + kstep, voffB);
        PG8_WAIT_V(6); PG8_BAR;
    }
    for (;;) {
        const bool has_next = S.next(ui + 1, nxt);
        const char* nA = has_next ? (const char*)g.A + (size_t)nxt.pm * tstep : cA; const char* nB = has_next ? (const char*)g.Bt + (size_t)nxt.pn * tstep : cB;
        for (int t = 0; t < nt; t += 2) {
            const bool last = (t == nt - 2);
            const char* a1 = cA + (size_t)(t + 1) * kstep;
            const char* a2 = last ? nA : cA + (size_t)(t + 2) * kstep; const char* b2 = last ? nB : cB + (size_t)(t + 2) * kstep;
            const char* a3 = a2 + kstep; const char* b3 = b2 + kstep;
            if (last && has_next) S.a_ready(nxt);
            if constexpr (Hook::ON) { if (t == Hook::T) H.mid(acc, cur, wr, wc, fr, fq); }
            if constexpr (SP2) {
            PG8_LDB(B0, 0, 0); PG8_LDB(B1, 0, 1); PG8_SCHED; PG8_LDA(At, 0, 0); PG8_STAGE(PG8_SA(1, 1), a1 + hstep, voffA);
            PG8_WAIT_V(8); PG8_WAIT_L(0); PG8_BAR; PG8_MMA(0, 0, At, B0); PG8_MMA(0, 1, At, B1); PG8_BAR; PG8_SCHED;
            PG8_LDA(At, 0, 1); PG8_STAGE(PG8_SB(0, 0), b2, voffB); PG8_STAGE(PG8_SB(0, 1), b2 + hstep, voffB); PG8_STAGE(PG8_SA(0, 0), a2, voffA);
            PG8_WAIT_V(8); PG8_WAIT_L(0); PG8_BAR; PG8_MMA(1, 0, At, B0); PG8_MMA(1, 1, At, B1); PG8_BAR; PG8_SCHED;
            PG8_LDB(B0, 1, 0); PG8_LDB(B1, 1, 1); PG8_SCHED; PG8_LDA(At, 1, 0); PG8_STAGE(PG8_SA(0, 1), a2 + hstep, voffA);
            PG8_WAIT_V(8); PG8_WAIT_L(0); PG8_BAR; PG8_MMA(0, 0, At, B0); PG8_MMA(0, 1, At, B1); PG8_BAR; PG8_SCHED;
            PG8_LDA(At, 1, 1); PG8_STAGE(PG8_SB(1, 0), b3, voffB); PG8_STAGE(PG8_SB(1, 1), b3 + hstep, voffB); PG8_STAGE(PG8_SA(1, 0), a3, voffA);
            PG8_WAIT_V(8); PG8_WAIT_L(0); PG8_BAR; PG8_MMA(1, 0, At, B0); PG8_MMA(1, 1, At, B1); PG8_BAR; PG8_SCHED;
            } else {
            PG8_LDB(B0, 0, 0); PG8_SCHED; PG8_LDA(At, 0, 0); PG8_STAGE(PG8_SA(1, 1), a1 + hstep, voffA);
            PG8_WAIT_L(8); PG8_BAR; PG8_WAIT_L(0); PG8_MMA(0, 0, At, B0); PG8_BAR; PG8_SCHED;
            PG8_LDB(B1, 0, 1); PG8_STAGE(PG8_SB(0, 0), b2, voffB);
            PG8_BAR; PG8_WAIT_L(0); PG8_MMA(0, 1, At, B1); PG8_BAR;
            PG8_LDA(At, 0, 1); PG8_STAGE(PG8_SA(0, 0), a2, voffA);
            PG8_BAR; PG8_WAIT_L(0); PG8_MMA(1, 0, At, B0); PG8_BAR; PG8_SCHED;
            PG8_STAGE(PG8_SB(0, 1), b2 + hstep, voffB);
            PG8_WAIT_V(6); PG8_BAR; PG8_MMA(1, 1, At, B1); PG8_BAR;
            PG8_LDB(B0, 1, 0); PG8_SCHED; PG8_LDA(At, 1, 0); PG8_STAGE(PG8_SA(0, 1), a2 + hstep, voffA);
            PG8_WAIT_L(8); PG8_BAR; PG8_WAIT_L(0); PG8_MMA(0, 0, At, B0); PG8_BAR; PG8_SCHED;
            PG8_LDB(B1, 1, 1); PG8_STAGE(PG8_SB(1, 0), b3, voffB);
            PG8_BAR; PG8_WAIT_L(0); PG8_MMA(0, 1, At, B1); PG8_BAR;
            PG8_LDA(At, 1, 1); PG8_STAGE(PG8_SA(1, 0), a3, voffA);
            PG8_BAR; PG8_WAIT_L(0); PG8_MMA(1, 0, At, B0); PG8_BAR; PG8_SCHED;
            PG8_STAGE(PG8_SB(1, 1), b3 + hstep, voffB);
            PG8_WAIT_V(6); PG8_BAR; PG8_MMA(1, 1, At, B1); PG8_BAR;
            }
        }
        if constexpr (ALIGN_EPI) { if (wr == 0) PG8_BAR; }
        if constexpr (!Epi::AFTER_DRAIN) { E(acc, cur, wr, wc, fr, fq); S.done(cur); }
        if (!has_next) break;
#pragma unroll
        for (int a = 0; a < 2; ++a)
#pragma unroll
            for (int b = 0; b < 2; ++b)
#pragma unroll
                for (int m = 0; m < 4; ++m)
#pragma unroll
                    for (int n = 0; n < 2; ++n) acc[a][b][m][n] = (f32x4){0.f, 0.f, 0.f, 0.f};
        cur = nxt; cA = nA; cB = nB; ++ui;
        if constexpr (ALIGN_EPI) { if (wr == 1) PG8_BAR; }
    }
    PG8_WAIT_V(0);
    if constexpr (!ALIGN_EPI) { if (wr == 0) PG8_BAR; }
    PG8_BAR;
    if constexpr (Epi::AFTER_DRAIN) { E.fused(acc, cur, wr, wc, fr, fq, lds, wid, lane); S.done(cur); }
#undef PG8_SA
#undef PG8_SB
#undef PG8_STAGE
#undef PG8_LDA
#undef PG8_LDB
#undef PG8_MMA
#undef PG8_WAIT_V
#undef PG8_WAIT_L
#undef PG8_BAR
#undef PG8_SCHED
}
}

namespace cg = cooperative_groups;
#ifndef PROBE_DUP
#define PROBE_DUP -1
#endif
#ifndef PROBE_DRY
#define PROBE_DRY 0
#endif
#ifndef STATIC_PLAN
#define STATIC_PLAN 0
#endif
#ifndef USE_SGB
#define USE_SGB 0
#endif
#ifndef FT_SEL
#define FT_SEL 1
#endif
#define LAS __attribute__((address_space(3)))
typedef unsigned short bf16_t;
typedef short bf16x8 __attribute__((ext_vector_type(8)));
typedef short s16x4 __attribute__((ext_vector_type(4)));
typedef float f32x4 __attribute__((ext_vector_type(4)));
typedef float f32x16 __attribute__((ext_vector_type(16)));
typedef unsigned u32x4 __attribute__((ext_vector_type(4)));
typedef unsigned u32x2 __attribute__((ext_vector_type(2)));

constexpr int DM = 2048, NB = 2, SEQ = 4096, MTOK = NB * SEQ;
constexpr int INW = 11328, INWP = 11520;
constexpr float EPS = 1e-6f;
constexpr float LOG2E = 1.4426950408889634f;
constexpr float QS_MLA = 0.07216878364870322f * LOG2E;
constexpr float QS_DIF = 0.125f * LOG2E;
constexpr float LAMBDA_INIT = 0.2f;

constexpr size_t MiB = 1u << 20;
constexpr size_t WS_CTL = 0;
constexpr size_t CTL_BYTES = 1 * MiB;
constexpr size_t WS_ROPE = 2 * MiB;
constexpr size_t WS_WUKV = 4 * MiB, WS_WOM = 6 * MiB, WS_WOD = 10 * MiB, WS_WOUT = 14 * MiB, WS_WIN = 22 * MiB;
constexpr size_t WS_H = 67 * MiB;
constexpr size_t WS_QM = 99 * MiB, WS_CKV = 123 * MiB, WS_KM = 131 * MiB, WS_VM = 155 * MiB;
constexpr size_t WS_QD = 171 * MiB, WS_KD = 187 * MiB, WS_VD = 203 * MiB, WS_GM = 219 * MiB, WS_GD = 235 * MiB;
constexpr size_t WS_SM = 251 * MiB, WS_SD = 283 * MiB, WS_OA = 315 * MiB, WS_END = 347 * MiB;
constexpr size_t WS_Y = 99 * MiB;
constexpr int CTL_BAR = 32768;
constexpr int CTL_SSQC = 0, CTL_SSQY = 8192, CTL_ADA = 16384, CTL_QUEUE = 16384 + 12288;

constexpr int LDS_MAIN = 131072, LDS_MISC = 131072, LDS_BYTES = 135168;

__device__ __forceinline__ unsigned f2bf(float f) { unsigned u = __builtin_bit_cast(unsigned, f); return (u + 0x7fffu + ((u >> 16) & 1u)) >> 16; }
typedef float f32x2_t __attribute__((ext_vector_type(2))); typedef __bf16 bf16x2_t __attribute__((ext_vector_type(2)));
__device__ __forceinline__ unsigned pk2(float lo, float hi) { f32x2_t v = {lo, hi}; bf16x2_t b = __builtin_convertvector(v, bf16x2_t); return __builtin_bit_cast(unsigned, b); }
__device__ __forceinline__ float fexp2(float v) { return __builtin_amdgcn_exp2f(v); }
__device__ __forceinline__ float bf2f(unsigned short b) { return __builtin_bit_cast(float, (unsigned)b << 16); }
__device__ __forceinline__ float bflo(unsigned w) { return __builtin_bit_cast(float, w << 16); }
__device__ __forceinline__ float bfhi(unsigned w) { return __builtin_bit_cast(float, w & 0xffff0000u); }
__device__ __forceinline__ float wave_sum(float v) {
#pragma unroll
    for (int o = 1; o < 64; o <<= 1) v += __shfl_xor(v, o);
    return v;
}
__device__ __forceinline__ float fsigmoid(float v) { return __builtin_amdgcn_rcpf(1.0f + fexp2(-1.4426950408889634f * v)); }

__device__ __forceinline__ int vsrc_in(int v) {
    if (v < 1536) { const int hd = v / 192, w = v - hd * 192; if (w < 128) return v; const int r = w - 128; return hd * 192 + 128 + (r >> 1) + 32 * (r & 1); }
    if (v < 2048) return v;
    if (v < 11264) return v + 64;
    if (v < 11328) { const int r = v - 11264; return 2048 + (r >> 1) + 32 * (r & 1); }
    return -1;
}

namespace epi {
using pg8::Unit;
__device__ __forceinline__ void st8(bf16_t* p, f32x4 a, f32x4 b) {
    u32x4 w; w.x = pk2(a[0], a[1]); w.y = pk2(a[2], a[3]); w.z = pk2(b[0], b[1]); w.w = pk2(b[2], b[3]); *(u32x4*)p = w;
}
__device__ __forceinline__ void rope8(f32x4& v0, f32x4& v1, const float* rc, const float* rs) {
    const f32x4 c4 = *(const f32x4*)rc, s4 = *(const f32x4*)rs;
    f32x4 a, b;
    a[0] = v0[0] * c4[0] - v0[1] * s4[0]; a[1] = v0[1] * c4[0] + v0[0] * s4[0];
    a[2] = v0[2] * c4[1] - v0[3] * s4[1]; a[3] = v0[3] * c4[1] + v0[2] * s4[1];
    b[0] = v1[0] * c4[2] - v1[1] * s4[2]; b[1] = v1[1] * c4[2] + v1[0] * s4[2];
    b[2] = v1[2] * c4[3] - v1[3] * s4[3]; b[3] = v1[3] * c4[3] + v1[2] * s4[3];
    v0 = a; v1 = b;
}
template <int ACT> __device__ __forceinline__ void store_tile(const f32x4 (&acc)[2][2][4][2], bf16_t* dst, int ldc, int colt, int rowb, int colw, float sc) {
#pragma unroll
    for (int ai = 0; ai < 2; ++ai)
#pragma unroll
        for (int m = 0; m < 4; ++m) { bf16_t* rowp = dst + (size_t)(rowb + ai * 128 + m * 16) * ldc + colt + colw;
#pragma unroll
            for (int bj = 0; bj < 2; ++bj) { f32x4 v0 = acc[ai][bj][m][0], v1 = acc[ai][bj][m][1];
                if (ACT == 1) { v0 = v0 * sc; v1 = v1 * sc; }
                if (ACT == 2) {
#pragma unroll
                    for (int i = 0; i < 4; ++i) { v0[i] = v0[i] * fsigmoid(v0[i]); v1[i] = v1[i] * fsigmoid(v1[i]); } }
                if (ACT == 3) {
#pragma unroll
                    for (int i = 0; i < 4; ++i) { v0[i] = fsigmoid(v0[i]); v1[i] = fsigmoid(v1[i]); } }
                st8(rowp + bj * 128, v0, v1); } }
}

struct EpiProj {
    static constexpr bool PERM = true, AFTER_DRAIN = false;
    bf16_t *QM, *CKV, *QD, *KD, *VD, *GM, *GD, *SM, *SD, *KM; float* ssq; const float* rc; const float* rs;
    __device__ __forceinline__ void operator()(const f32x4 (&acc)[2][2][4][2], const Unit& u, int wr, int wc, int fr, int fq) const {
        const int pn = u.pn, rowb = u.pm * 256 + wr * 64 + fr, colw = wc * 32 + 8 * fq;
        if (pn < 6) {
#pragma unroll
            for (int bj = 0; bj < 2; ++bj) { const int col = pn * 256 + bj * 128 + colw, w = col % 192; const bool rp = w >= 128; const int i0 = (w - 128) >> 1;
#pragma unroll
                for (int ai = 0; ai < 2; ++ai)
#pragma unroll
                    for (int m = 0; m < 4; ++m) { const int row = rowb + ai * 128 + m * 16; f32x4 v0 = acc[ai][bj][m][0], v1 = acc[ai][bj][m][1];
                        if (rp) rope8(v0, v1, rc + (size_t)row * 32 + i0, rs + (size_t)row * 32 + i0);
                        v0 = v0 * QS_MLA; v1 = v1 * QS_MLA; st8(QM + (size_t)row * 1536 + col, v0, v1); } }
        } else if (pn < 8) {
            const int colt = (pn - 6) * 256;
#pragma unroll
            for (int ai = 0; ai < 2; ++ai)
#pragma unroll
                for (int m = 0; m < 4; ++m) { const int row = rowb + ai * 128 + m * 16; float s = 0.f;
#pragma unroll
                    for (int bj = 0; bj < 2; ++bj) { const f32x4 v0 = acc[ai][bj][m][0], v1 = acc[ai][bj][m][1];
                        s += (v0[0] * v0[0] + v0[1] * v0[1]) + (v0[2] * v0[2] + v0[3] * v0[3]) + (v1[0] * v1[0] + v1[1] * v1[1]) + (v1[2] * v1[2] + v1[3] * v1[3]);
                        st8(CKV + (size_t)row * 512 + colt + bj * 128 + colw, v0, v1); }
                    s += __shfl_xor(s, 16); s += __shfl_xor(s, 32);
                    if (fq == 0) atomicAdd(ssq + row, s); }
        } else if (pn < 12) store_tile<1>(acc, QD, 1024, (pn - 8) * 256, rowb, colw, QS_DIF);
        else if (pn < 16) store_tile<0>(acc, KD, 1024, (pn - 12) * 256, rowb, colw, 1.f);
        else if (pn < 20) store_tile<0>(acc, VD, 1024, (pn - 16) * 256, rowb, colw, 1.f);
        else if (pn < 24) store_tile<2>(acc, GM, 1024, (pn - 20) * 256, rowb, colw, 1.f);
        else if (pn < 28) store_tile<2>(acc, GD, 1024, (pn - 24) * 256, rowb, colw, 1.f);
        else if (pn < 36) store_tile<3>(acc, SM, 2048, (pn - 28) * 256, rowb, colw, 1.f);
        else if (pn < 44) store_tile<3>(acc, SD, 2048, (pn - 36) * 256, rowb, colw, 1.f);
        else {
            if (wc < 2) { const int i0 = colw >> 1;
#pragma unroll
                for (int ai = 0; ai < 2; ++ai)
#pragma unroll
                    for (int m = 0; m < 4; ++m) { const int row = rowb + ai * 128 + m * 16; f32x4 v0 = acc[ai][0][m][0], v1 = acc[ai][0][m][1];
                        rope8(v0, v1, rc + (size_t)row * 32 + i0, rs + (size_t)row * 32 + i0);
                        const int b = row >> 12, s = row & 4095;
#pragma unroll
                        for (int h = 0; h < 8; ++h) st8(KM + ((size_t)(b * 8 + h) * SEQ + s) * 192 + 128 + colw, v0, v1); } }
        }
    }
};
struct EpiUp {
    static constexpr bool PERM = true, AFTER_DRAIN = false;
    bf16_t *KM, *VM; const float* ssq;
    __device__ __forceinline__ void operator()(const f32x4 (&acc)[2][2][4][2], const Unit& u, int wr, int wc, int fr, int fq) const {
        const int h = u.pn, rowb = u.pm * 256 + wr * 64 + fr, colw = wc * 32 + 8 * fq;
#pragma unroll
        for (int ai = 0; ai < 2; ++ai)
#pragma unroll
            for (int m = 0; m < 4; ++m) { const int row = rowb + ai * 128 + m * 16; const float r = rsqrtf(ssq[row] * (1.0f / 512.0f) + EPS);
                const int b = row >> 12, s = row & 4095;
                st8(KM + ((size_t)(b * 8 + h) * SEQ + s) * 192 + colw, acc[ai][0][m][0] * r, acc[ai][0][m][1] * r);
                st8(VM + (size_t)row * 1024 + h * 128 + colw, acc[ai][1][m][0] * r, acc[ai][1][m][1] * r); }
    }
};
struct EpiO1 {
    static constexpr bool PERM = true, AFTER_DRAIN = false;
    bf16_t* Y; const bf16_t* S;
    __device__ __forceinline__ void operator()(const f32x4 (&acc)[2][2][4][2], const Unit& u, int wr, int wc, int fr, int fq) const {
        const int rowb = u.pm * 256 + wr * 64 + fr, colb = u.pn * 256 + wc * 32 + 8 * fq;
#pragma unroll
        for (int ai = 0; ai < 2; ++ai)
#pragma unroll
            for (int m = 0; m < 4; ++m)
#pragma unroll
                for (int bj = 0; bj < 2; ++bj) { const size_t off = (size_t)(rowb + ai * 128 + m * 16) * DM + colb + bj * 128;
                    const u32x4 g = *(const u32x4*)(S + off); f32x4 v0 = acc[ai][bj][m][0], v1 = acc[ai][bj][m][1];
                    v0[0] *= bflo(g.x); v0[1] *= bfhi(g.x); v0[2] *= bflo(g.y); v0[3] *= bfhi(g.y); v1[0] *= bflo(g.z); v1[1] *= bfhi(g.z); v1[2] *= bflo(g.w); v1[3] *= bfhi(g.w);
                    st8(Y + off, v0, v1); }
    }
};
struct EpiO2 {
    static constexpr bool PERM = true, AFTER_DRAIN = false;
    const bf16_t* Y; const bf16_t* S; bf16_t* MG;
    __device__ __forceinline__ void operator()(const f32x4 (&acc)[2][2][4][2], const Unit& u, int wr, int wc, int fr, int fq) const {
        const int rowb = u.pm * 256 + wr * 64 + fr, colb = u.pn * 256 + wc * 32 + 8 * fq;
#pragma unroll
        for (int ai = 0; ai < 2; ++ai)
#pragma unroll
            for (int m = 0; m < 4; ++m)
#pragma unroll
                for (int bj = 0; bj < 2; ++bj) { const size_t off = (size_t)(rowb + ai * 128 + m * 16) * DM + colb + bj * 128;
                    const u32x4 g = *(const u32x4*)(S + off); f32x4 v0 = acc[ai][bj][m][0], v1 = acc[ai][bj][m][1];
                    const u32x4 yy = *(const u32x4*)(Y + off); const f32x4 y0 = {bflo(yy.x), bfhi(yy.x), bflo(yy.y), bfhi(yy.y)}, y1 = {bflo(yy.z), bfhi(yy.z), bflo(yy.w), bfhi(yy.w)};
                    v0[0] = y0[0] + v0[0] * bflo(g.x); v0[1] = y0[1] + v0[1] * bfhi(g.x); v0[2] = y0[2] + v0[2] * bflo(g.y); v0[3] = y0[3] + v0[3] * bfhi(g.y);
                    v1[0] = y1[0] + v1[0] * bflo(g.z); v1[1] = y1[1] + v1[1] * bfhi(g.z); v1[2] = y1[2] + v1[2] * bflo(g.w); v1[3] = y1[3] + v1[3] * bfhi(g.w);
                    st8(MG + off, v0, v1); }
    }
};
struct HookMerge {
    static constexpr bool ON = true; static constexpr int T = 16;
    const bf16_t *SMp, *SDp;
    __device__ __forceinline__ void mid(f32x4 (&acc)[2][2][4][2], const Unit& u, int wr, int wc, int fr, int fq) const {
        int rowb = u.pm * 256 + wr * 64 + fr, colb = u.pn * 256 + wc * 32 + 8 * fq;
        asm volatile("" : "+v"(rowb), "+v"(colb));
#pragma unroll
        for (int ai = 0; ai < 2; ++ai)
#pragma unroll
            for (int m = 0; m < 4; ++m) {
#pragma unroll
                for (int bj = 0; bj < 2; ++bj) { const size_t off = (size_t)(rowb + ai * 128 + m * 16) * DM + colb + bj * 128;
                    const u32x4 a = *(const u32x4*)(SMp + off), d = *(const u32x4*)(SDp + off);
                    f32x4 r0, r1;
                    r0[0] = bflo(a.x) * __builtin_amdgcn_rcpf(bflo(d.x)); r0[1] = bfhi(a.x) * __builtin_amdgcn_rcpf(bfhi(d.x)); r0[2] = bflo(a.y) * __builtin_amdgcn_rcpf(bflo(d.y)); r0[3] = bfhi(a.y) * __builtin_amdgcn_rcpf(bfhi(d.y));
                    r1[0] = bflo(a.z) * __builtin_amdgcn_rcpf(bflo(d.z)); r1[1] = bfhi(a.z) * __builtin_amdgcn_rcpf(bfhi(d.z)); r1[2] = bflo(a.w) * __builtin_amdgcn_rcpf(bflo(d.w)); r1[3] = bfhi(a.w) * __builtin_amdgcn_rcpf(bfhi(d.w));
                    acc[ai][bj][m][0] = acc[ai][bj][m][0] * r0; acc[ai][bj][m][1] = acc[ai][bj][m][1] * r1; }
                if (m & 1) asm volatile("" ::: "memory");
            }
    }
};
struct EpiMerge {
    static constexpr bool PERM = true, AFTER_DRAIN = false;
    const bf16_t* S; bf16_t* MG;
    __device__ __forceinline__ void operator()(const f32x4 (&acc)[2][2][4][2], const Unit& u, int wr, int wc, int fr, int fq) const {
        const int rowb = u.pm * 256 + wr * 64 + fr, colb = u.pn * 256 + wc * 32 + 8 * fq;
#pragma unroll
        for (int ai = 0; ai < 2; ++ai)
#pragma unroll
            for (int m = 0; m < 4; ++m)
#pragma unroll
                for (int bj = 0; bj < 2; ++bj) { const size_t off = (size_t)(rowb + ai * 128 + m * 16) * DM + colb + bj * 128;
                    const u32x4 g = *(const u32x4*)(S + off); f32x4 v0 = acc[ai][bj][m][0], v1 = acc[ai][bj][m][1];
                    v0[0] *= bflo(g.x); v0[1] *= bfhi(g.x); v0[2] *= bflo(g.y); v0[3] *= bfhi(g.y); v1[0] *= bflo(g.z); v1[1] *= bfhi(g.z); v1[2] *= bflo(g.w); v1[3] *= bfhi(g.w);
                    st8(MG + off, v0, v1); }
    }
};
struct EpiOut {
    static constexpr bool PERM = true, AFTER_DRAIN = false;
    bf16_t* Y; float* ssq;
    __device__ __forceinline__ void operator()(const f32x4 (&acc)[2][2][4][2], const Unit& u, int wr, int wc, int fr, int fq) const {
        const int rowb = u.pm * 256 + wr * 64 + fr, colb = u.pn * 256 + wc * 32 + 8 * fq;
#pragma unroll
        for (int ai = 0; ai < 2; ++ai)
#pragma unroll
            for (int m = 0; m < 4; ++m) { const int row = rowb + ai * 128 + m * 16; float s = 0.f;
#pragma unroll
                for (int bj = 0; bj < 2; ++bj) { const size_t off = (size_t)row * DM + colb + bj * 128; const f32x4 v0 = acc[ai][bj][m][0], v1 = acc[ai][bj][m][1];
                    s += (v0[0] * v0[0] + v0[1] * v0[1]) + (v0[2] * v0[2] + v0[3] * v0[3]) + (v1[0] * v1[0] + v1[1] * v1[1]) + (v1[2] * v1[2] + v1[3] * v1[3]);
                    st8(Y + off, v0, v1); }
                s += __shfl_xor(s, 16); s += __shfl_xor(s, 32);
                if (fq == 0) atomicAdd(ssq + row, s); }
    }
};
}

namespace att {
constexpr int KBUF = 25600, VBUF = 20480, VROW = 320;
constexpr int OFF_K = 0, OFF_V = 2 * KBUF, OFF_POS = OFF_V + 2 * VBUF, OFF_WSF = OFF_POS + 512, OFF_END = OFF_WSF + 8 * 256;
static_assert(OFF_END <= LDS_MAIN, "attention LDS");
constexpr float NEG = -1e30f;
struct Ptrs { const bf16_t *QM, *KM, *VM, *QD, *KD, *VD, *GM, *GD; bf16_t *OM, *OD; const int* pos; const float* gsub; float lam; };
__device__ __forceinline__ int crow(int r, int hi) { return (r & 3) + 8 * (r >> 2) + 4 * hi; }
__device__ __forceinline__ float xmax(float v) { const unsigned u = __float_as_uint(v); auto rr = __builtin_amdgcn_permlane32_swap(u, u, false, false); return fmaxf(__uint_as_float(rr[0]), __uint_as_float(rr[1])); }
__device__ __forceinline__ float xsum(float v) { const unsigned u = __float_as_uint(v); auto rr = __builtin_amdgcn_permlane32_swap(u, u, false, false); return __uint_as_float(rr[0]) + __uint_as_float(rr[1]); }
__device__ __forceinline__ s16x4 vtr(const LAS unsigned char* p) { return __builtin_bit_cast(s16x4, __builtin_amdgcn_ds_read_tr16_b64_v4i16((LAS s16x4*)p)); }
__device__ __forceinline__ bf16x8 pack8(const f32x16& p, int s) {
    u32x4 w; w.x = pk2(p[8 * s + 0], p[8 * s + 1]); w.y = pk2(p[8 * s + 2], p[8 * s + 3]); w.z = pk2(p[8 * s + 4], p[8 * s + 5]); w.w = pk2(p[8 * s + 6], p[8 * s + 7]);
    return __builtin_bit_cast(bf16x8, w);
}

template <bool MLA> __device__ __forceinline__ void sm_fast(f32x16& p, float& lrun, const LAS float* pp, float posq, float slope2, bf16x8& pa0, bf16x8& pa1) {
    if (!MLA) {
#pragma unroll
        for (int g = 0; g < 4; ++g) { const f32x4 a = *(const LAS f32x4*)(pp + 8 * g);
#pragma unroll
            for (int i = 0; i < 4; ++i) p[4 * g + i] -= slope2 * fabsf(posq - a[i]); }
    }
    float rs0 = 0.f, rs1 = 0.f, rs2 = 0.f, rs3 = 0.f;
#pragma unroll
    for (int r = 0; r < 16; r += 4) { p[r] = fexp2(p[r]); p[r + 1] = fexp2(p[r + 1]); p[r + 2] = fexp2(p[r + 2]); p[r + 3] = fexp2(p[r + 3]);
        rs0 += p[r]; rs1 += p[r + 1]; rs2 += p[r + 2]; rs3 += p[r + 3]; }
    lrun += (rs0 + rs1) + (rs2 + rs3);
    pa0 = pack8(p, 0); pa1 = pack8(p, 1);
}
template <bool MLA, bool SAFE> __device__ __forceinline__ int attn_unit(LAS unsigned char* lds, const int b, const int h, const int qb, const Ptrs& P, const int dry) {
    constexpr int ROWS = MLA ? 256 : 128, DK = MLA ? 192 : 64, DKT = MLA ? 192 : 128, KROW = DKT * 2 + 16, CPR = DKT / 8, KCH = (64 * CPR) / 512, ND = DK / 16;
    int tid_ = threadIdx.x; asm volatile("" : "+v"(tid_));
    const int tid = tid_, lane = tid & 63, wid = __builtin_amdgcn_readfirstlane(tid >> 6), r32 = lane & 31, hi = lane >> 5;
    const int rg = MLA ? wid : (wid >> 1), c = MLA ? 0 : (wid & 1);
    const int q0 = qb * ROWS, q0w = q0 + 32 * rg, qabs = q0w + r32;
    const size_t tokb = (size_t)b * SEQ;
    const bf16_t* Kg = MLA ? P.KM + ((size_t)(b * 8 + h) * SEQ) * 192 : P.KD + tokb * 1024 + h * 128;
    constexpr int KLD = MLA ? 192 : 1024;
    const bf16_t* Vg = (MLA ? P.VM : P.VD) + tokb * 1024 + h * 128;
    bf16x8 qf[ND];
    { const bf16_t* Qg = MLA ? P.QM + (tokb + qabs) * 1536 + h * 192 : P.QD + (tokb + qabs) * 1024 + h * 128 + c * 64;
#pragma unroll
      for (int d0 = 0; d0 < ND; ++d0) qf[d0] = *(const bf16x8*)(Qg + d0 * 16 + hi * 8); }
    float posq = 0.f, slope2 = 0.f;
    if (!MLA) { posq = (float)P.pos[tokb + qabs]; slope2 = exp2f(-(float)(h + 1)) * LOG2E; }
#pragma unroll
    for (int d0 = 0; d0 < ND; ++d0) asm volatile("" : "+v"(qf[d0]));
    asm volatile("" : "+v"(posq), "+v"(slope2));
    u32x4 kreg[KCH], vreg[2]; int preg = 0;
    int krow[KCH], kch[KCH], vrow[2], vch[2];
#pragma unroll
    for (int i = 0; i < KCH; ++i) { const int idx = tid + 512 * i; krow[i] = idx / CPR; kch[i] = idx % CPR; }
#pragma unroll
    for (int i = 0; i < 2; ++i) { const int idx = tid + 512 * i; vrow[i] = idx >> 4; vch[i] = idx & 15; }
#define ATT_LOAD(j) do { const int kv0_ = 64 * (j); \
        _Pragma("unroll") for (int i = 0; i < KCH; ++i) kreg[i] = *(const u32x4*)(Kg + (size_t)(kv0_ + krow[i]) * KLD + kch[i] * 8); \
        _Pragma("unroll") for (int i = 0; i < 2; ++i) vreg[i] = *(const u32x4*)(Vg + (size_t)(kv0_ + vrow[i]) * 1024 + vch[i] * 8); \
        if (!MLA) { if (tid < 64) preg = P.pos[tokb + kv0_ + tid]; } } while (0)
#define ATT_WRITE(bf) do { \
        _Pragma("unroll") for (int i = 0; i < KCH; ++i) *(LAS u32x4*)(lds + OFF_K + (bf) * KBUF + krow[i] * KROW + kch[i] * 16) = kreg[i]; \
        _Pragma("unroll") for (int i = 0; i < 2; ++i) *(LAS u32x4*)(lds + OFF_V + (bf) * VBUF + vrow[i] * VROW + vch[i] * 16) = vreg[i]; \
        if (!MLA) { if (tid < 64) *(LAS float*)(lds + OFF_POS + (bf) * 256 + tid * 4) = (float)preg; } } while (0)

    LAS float* wsf = (LAS float*)(lds + OFF_WSF + wid * 256);
    f32x16 o[4];
#pragma unroll
    for (int d = 0; d < 4; ++d)
#pragma unroll
        for (int r = 0; r < 16; ++r) o[d][r] = 0.f;
    float mrun = NEG, lrun = 0.f;
    const int NT = (q0 + ROWS) / 64;
    const int kbase = (r32)*KROW + c * 128 + hi * 16;
    const int vbase = (4 * hi + ((lane & 15) >> 2)) * VROW + (((lane >> 4) & 1) * 16 + (lane & 3) * 4) * 2;

    ATT_LOAD(0);
    __syncthreads();
    ATT_WRITE(0);
    const int JB = (FT_SEL && !SAFE && !dry) ? (q0 >> 6) : 0;
    for (int j = 0; j < JB; ++j) {
        const int bf = j & 1;
        if (j + 1 < NT) ATT_LOAD(j + 1);
        __syncthreads();
        {
            constexpr int NV1 = MLA ? 4 : 19, NV2 = MLA ? 6 : 10;
            const LAS unsigned char* KbA = lds + OFF_K + bf * KBUF + kbase;
            const LAS unsigned char* Vb = lds + OFF_V + bf * VBUF + vbase;
            const LAS float* pp = (const LAS float*)(lds + OFF_POS + bf * 256) + 4 * hi;
            constexpr int KBT = 4;
            f32x16 pA, pB;
#pragma unroll
            for (int r = 0; r < 16; ++r) { pA[r] = 0.f; pB[r] = 0.f; }
#pragma unroll
            for (int hb = 0; hb < ND / KBT; ++hb) {
                bf16x8 kf[KBT];
#pragma unroll
                for (int i = 0; i < KBT; ++i) kf[i] = *(const LAS bf16x8*)(KbA + (hb * KBT + i) * 32);
                __builtin_amdgcn_sched_barrier(0);
#pragma unroll
                for (int i = 0; i < KBT; ++i) pA = __builtin_amdgcn_mfma_f32_32x32x16_bf16(kf[i], qf[hb * KBT + i], pA, 0, 0, 0);
                __builtin_amdgcn_sched_barrier(0);
            }
            bf16x8 paA0, paA1, paB0, paB1;
#pragma unroll
            for (int hb = 0; hb < ND / KBT; ++hb) {
                bf16x8 kf[KBT];
#pragma unroll
                for (int i = 0; i < KBT; ++i) kf[i] = *(const LAS bf16x8*)(KbA + 32 * KROW + (hb * KBT + i) * 32);
                if (hb + 1 < ND / KBT) __builtin_amdgcn_sched_barrier(0);
#pragma unroll
                for (int i = 0; i < KBT; ++i) pB = __builtin_amdgcn_mfma_f32_32x32x16_bf16(kf[i], qf[hb * KBT + i], pB, 0, 0, 0);
            }
            sm_fast<MLA>(pA, lrun, pp, posq, slope2, paA0, paA1);
            __builtin_amdgcn_sched_barrier(0);
#pragma unroll
            for (int s2 = 0; s2 < 2; ++s2) {
                s16x4 vlo[4], vhi[4];
#pragma unroll
                for (int db = 0; db < 4; ++db) { vlo[db] = vtr(Vb + s2 * 16 * VROW + db * 64); vhi[db] = vtr(Vb + s2 * 16 * VROW + 8 * VROW + db * 64); }
#pragma unroll
                for (int db = 0; db < 4; ++db) { const bf16x8 vb = (bf16x8){vlo[db][0], vlo[db][1], vlo[db][2], vlo[db][3], vhi[db][0], vhi[db][1], vhi[db][2], vhi[db][3]};
                    o[db] = __builtin_amdgcn_mfma_f32_32x32x16_bf16(s2 ? paA1 : paA0, vb, o[db], 0, 0, 0); }
            }
            sm_fast<MLA>(pB, lrun, pp + 32, posq, slope2, paB0, paB1);
            __builtin_amdgcn_sched_barrier(0);
#pragma unroll
            for (int s2 = 0; s2 < 2; ++s2) {
                s16x4 vlo[4], vhi[4];
#pragma unroll
                for (int db = 0; db < 4; ++db) { vlo[db] = vtr(Vb + 32 * VROW + s2 * 16 * VROW + db * 64); vhi[db] = vtr(Vb + 32 * VROW + s2 * 16 * VROW + 8 * VROW + db * 64); }
#pragma unroll
                for (int db = 0; db < 4; ++db) { const bf16x8 vb = (bf16x8){vlo[db][0], vlo[db][1], vlo[db][2], vlo[db][3], vhi[db][0], vhi[db][1], vhi[db][2], vhi[db][3]};
                    o[db] = __builtin_amdgcn_mfma_f32_32x32x16_bf16(s2 ? paB1 : paB0, vb, o[db], 0, 0, 0); }
            }
        }
        if (j + 1 < NT) ATT_WRITE(bf ^ 1);
    }
    for (int j = JB; j < NT; ++j) {
        const int bf = j & 1;
        if (j + 1 < NT && !(dry & 4)) ATT_LOAD(j + 1);
        __syncthreads();
        const int kv0 = 64 * j;
#pragma unroll 2
        for (int kvh = 0; kvh < 2; ++kvh) {
            const int kvs = kv0 + 32 * kvh;
            if (kvs > q0w + 31 || (dry & 1) || ((dry & 8) && (wid & 4))) break;
            const LAS unsigned char* Kb = lds + OFF_K + bf * KBUF + kbase + kvh * 32 * KROW;
            bf16x8 kf[ND];
#pragma unroll
            for (int d0 = 0; d0 < ND; ++d0) kf[d0] = *(const LAS bf16x8*)(Kb + d0 * 32);
            __builtin_amdgcn_sched_barrier(0);
            f32x16 p;
#pragma unroll
            for (int r = 0; r < 16; ++r) p[r] = 0.f;
#pragma unroll
            for (int d0 = 0; d0 < ND; ++d0) p = __builtin_amdgcn_mfma_f32_32x32x16_bf16(kf[d0], qf[d0], p, 0, 0, 0);
            if (SAFE) __builtin_amdgcn_sched_barrier(0);
            const LAS unsigned char* Vb = lds + OFF_V + bf * VBUF + vbase + kvh * 32 * VROW;
            s16x4 vlo[8], vhi[8];
#pragma unroll
            for (int s2 = 0; s2 < 2; ++s2)
#pragma unroll
                for (int db = 0; db < 4; ++db) { vlo[s2 * 4 + db] = vtr(Vb + s2 * 16 * VROW + db * 64); vhi[s2 * 4 + db] = vtr(Vb + s2 * 16 * VROW + 8 * VROW + db * 64); }
            if (SAFE) __builtin_amdgcn_sched_barrier(0);
            if (!MLA) {
                const LAS float* pp = (const LAS float*)(lds + OFF_POS + bf * 256) + 32 * kvh + 4 * hi;
#pragma unroll
                for (int g = 0; g < 4; ++g) { const f32x4 a = *(const LAS f32x4*)(pp + 8 * g);
#pragma unroll
                    for (int i = 0; i < 4; ++i) p[4 * g + i] -= slope2 * fabsf(posq - a[i]); }
            }
            if (kvs + 31 > q0w) {
#pragma unroll
                for (int r = 0; r < 16; ++r) { if (kvs + crow(r, hi) > qabs) p[r] = NEG; }
            }
            if (SAFE) {
            float mx;
            { const float m0 = fmaxf(fmaxf(p[0], p[1]), fmaxf(p[2], p[3])), m1 = fmaxf(fmaxf(p[4], p[5]), fmaxf(p[6], p[7]));
              const float m2 = fmaxf(fmaxf(p[8], p[9]), fmaxf(p[10], p[11])), m3 = fmaxf(fmaxf(p[12], p[13]), fmaxf(p[14], p[15]));
              mx = fmaxf(fmaxf(m0, m1), fmaxf(m2, m3)); }
            mx = xmax(mx);
            const float mnew = fmaxf(mrun, mx), alpha = fexp2(mrun - mnew);
            mrun = mnew;
            float rs0 = 0.f, rs1 = 0.f, rs2 = 0.f, rs3 = 0.f;
#pragma unroll
            for (int r = 0; r < 16; r += 4) { p[r] = fexp2(p[r] - mnew); p[r + 1] = fexp2(p[r + 1] - mnew); p[r + 2] = fexp2(p[r + 2] - mnew); p[r + 3] = fexp2(p[r + 3] - mnew);
                rs0 += p[r]; rs1 += p[r + 1]; rs2 += p[r + 2]; rs3 += p[r + 3]; }
            lrun = lrun * alpha + ((rs0 + rs1) + (rs2 + rs3));
            if (__any(alpha != 1.0f)) {
                if (hi == 0) wsf[r32] = alpha;
#pragma unroll
                for (int g = 0; g < 4; ++g) { const f32x4 a4 = *(const LAS f32x4*)(wsf + 8 * g + 4 * hi);
#pragma unroll
                    for (int d = 0; d < 4; ++d)
#pragma unroll
                        for (int i = 0; i < 4; ++i) o[d][4 * g + i] *= a4[i]; }
            }
            } else {
            float rs0 = 0.f, rs1 = 0.f, rs2 = 0.f, rs3 = 0.f;
#pragma unroll
            for (int r = 0; r < 16; r += 4) { p[r] = fexp2(p[r]); p[r + 1] = fexp2(p[r + 1]); p[r + 2] = fexp2(p[r + 2]); p[r + 3] = fexp2(p[r + 3]);
                rs0 += p[r]; rs1 += p[r + 1]; rs2 += p[r + 2]; rs3 += p[r + 3]; }
            lrun += (rs0 + rs1) + (rs2 + rs3);
            }
            if (SAFE) __builtin_amdgcn_sched_barrier(0);
#pragma unroll
            for (int s2 = 0; s2 < 2; ++s2) {
                const bf16x8 pa = pack8(p, s2);
#pragma unroll
                for (int db = 0; db < 4; ++db) {
                    const s16x4 lo = vlo[s2 * 4 + db], hh = vhi[s2 * 4 + db];
                    const bf16x8 vb = (bf16x8){lo[0], lo[1], lo[2], lo[3], hh[0], hh[1], hh[2], hh[3]};
                    o[db] = __builtin_amdgcn_mfma_f32_32x32x16_bf16(pa, vb, o[db], 0, 0, 0);
                }
            }
        }
        if (j + 1 < NT && !(dry & 4)) ATT_WRITE(bf ^ 1);
    }
#undef ATT_LOAD
#undef ATT_WRITE
    int q0e = q0w, r32e = r32, hie = hi; asm volatile("" : "+s"(q0e), "+v"(r32e), "+v"(hie));
    if (dry) { if (dry & 1) asm volatile("" :: "v"(qf[0]), "v"(qf[ND - 1])); else asm volatile("" :: "v"(o[0]), "v"(o[1]), "v"(o[2]), "v"(o[3]), "v"(lrun)); return 0; }
    float lt = xsum(lrun);
    const int bad = SAFE ? 0 : (int)__any(!(lt < 1e30f));
    if (hie == 0) wsf[32 + r32e] = 1.0f / lt;
    f32x4 li[4];
#pragma unroll
    for (int g = 0; g < 4; ++g) li[g] = *(const LAS f32x4*)(wsf + 32 + 8 * g + 4 * hie);
    constexpr int SROW = 272;
    if (MLA) {
        __syncthreads();
        LAS unsigned char* stg = lds + wid * (32 * SROW);
#pragma unroll
        for (int r = 0; r < 16; ++r)
#pragma unroll
            for (int db = 0; db < 4; ++db) *(LAS bf16_t*)(stg + crow(r, hie) * SROW + (32 * db + r32e) * 2) = (bf16_t)f2bf(o[db][r] * li[r >> 2][r & 3]);
        asm volatile("s_waitcnt lgkmcnt(0)" ::: "memory");
#pragma unroll
        for (int i = 0; i < 8; ++i) { const int idx = i * 64 + lane, row = idx >> 4, ch = idx & 15;
            const u32x4 ov = *(const LAS u32x4*)(stg + row * SROW + ch * 16);
            const size_t off = (tokb + q0e + row) * 1024 + h * 128 + ch * 8, offo = (tokb + q0e + row) * 2048 + h * 128 + ch * 8;
            const u32x4 g = *(const u32x4*)(P.GM + off);
            u32x4 w; w.x = pk2(bflo(ov.x) * bflo(g.x), bfhi(ov.x) * bfhi(g.x)); w.y = pk2(bflo(ov.y) * bflo(g.y), bfhi(ov.y) * bfhi(g.y));
            w.z = pk2(bflo(ov.z) * bflo(g.z), bfhi(ov.z) * bfhi(g.z)); w.w = pk2(bflo(ov.w) * bflo(g.w), bfhi(ov.w) * bfhi(g.w));
            *(u32x4*)(P.OM + offo) = w; }
    } else {
        LAS float* comb = (LAS float*)lds;
        __syncthreads();
        if (c == 1) {
#pragma unroll
            for (int r = 0; r < 16; ++r)
#pragma unroll
                for (int db = 0; db < 4; ++db) comb[((rg * 16 + r) * 2 + hie) * 128 + db * 32 + r32e] = o[db][r] * li[r >> 2][r & 3];
        }
        __syncthreads();
        if (c == 0) {
            float gs[4];
#pragma unroll
            for (int db = 0; db < 4; ++db) gs[db] = P.gsub[32 * db + r32e] * (1.0f - LAMBDA_INIT);
#pragma unroll
            for (int r = 0; r < 16; ++r)
#pragma unroll
                for (int db = 0; db < 4; ++db) o[db][r] = o[db][r] * li[r >> 2][r & 3] - P.lam * comb[((rg * 16 + r) * 2 + hie) * 128 + db * 32 + r32e];
            asm volatile("s_waitcnt lgkmcnt(0)" ::: "memory");
            LAS unsigned char* stg = lds + rg * 16384;
#pragma unroll
            for (int r = 0; r < 16; ++r) { float ss = 0.f;
#pragma unroll
                for (int db = 0; db < 4; ++db) ss += o[db][r] * o[db][r];
                ss += __shfl_xor(ss, 1); ss += __shfl_xor(ss, 2); ss += __shfl_xor(ss, 4); ss += __shfl_xor(ss, 8); ss += __shfl_xor(ss, 16);
                const float rstd = rsqrtf(ss * (1.0f / 128.0f) + EPS);
#pragma unroll
                for (int db = 0; db < 4; ++db) *(LAS bf16_t*)(stg + crow(r, hie) * SROW + (32 * db + r32e) * 2) = (bf16_t)f2bf(o[db][r] * rstd * gs[db]); }
            asm volatile("s_waitcnt lgkmcnt(0)" ::: "memory");
#pragma unroll
            for (int i = 0; i < 8; ++i) { const int idx = i * 64 + lane, row = idx >> 4, ch = idx & 15;
                const u32x4 ov = *(const LAS u32x4*)(stg + row * SROW + ch * 16);
                const size_t off = (tokb + q0e + row) * 1024 + h * 128 + ch * 8, offo = (tokb + q0e + row) * 2048 + 1024 + h * 128 + ch * 8;
                const u32x4 g = *(const u32x4*)(P.GD + off);
                u32x4 w; w.x = pk2(bflo(ov.x) * bflo(g.x), bfhi(ov.x) * bfhi(g.x)); w.y = pk2(bflo(ov.y) * bflo(g.y), bfhi(ov.y) * bfhi(g.y));
                w.z = pk2(bflo(ov.z) * bflo(g.z), bfhi(ov.z) * bfhi(g.z)); w.w = pk2(bflo(ov.w) * bflo(g.w), bfhi(ov.w) * bfhi(g.w));
                *(u32x4*)(P.OD + offo) = w; }
        }
    }
    return bad;
}
}

#define XB_TMO      128
#define XB_XCNT(j)  (256  + 64 * (j))
#define XB_XSUB(j)  (1280 + 64 * (j))
#define XB_XGEN(j)  (2304 + 64 * (j))
#define XB_TOP      3328
#define XB_TOPGEN   3392
#define XCD_BAR_WORDS 3456
#define XB_SPIN_CAP (1u << 18)

__device__ __forceinline__ unsigned xb_ld(unsigned* p)              { return __hip_atomic_load(p, __ATOMIC_RELAXED, __HIP_MEMORY_SCOPE_AGENT); }
__device__ __forceinline__ unsigned xb_add(unsigned* p, unsigned v) { return __hip_atomic_fetch_add(p, v, __ATOMIC_RELAXED, __HIP_MEMORY_SCOPE_AGENT); }
__device__ __forceinline__ unsigned xb_xcc_id() { return (unsigned)__builtin_amdgcn_s_getreg((3 << 11) | 20) & 0xFu; }
#define XB_SPIN(cond, bar) do { unsigned _sp = 0; while (cond) { __builtin_amdgcn_s_sleep(1); \
    if ((++_sp & 255u) == 0u) { if (xb_ld(&(bar)[XB_TMO])) break; if (_sp > XB_SPIN_CAP) { atomicAdd(&(bar)[XB_TMO], 1u); break; } } } } while (0)

struct XcdBarrier {
    unsigned* bar; unsigned x;
    volatile LAS unsigned* st;
};

__device__ __forceinline__ XcdBarrier xcd_barrier_post(unsigned* bar, volatile LAS unsigned* st) {
    XcdBarrier b; b.bar = bar; b.x = xb_xcc_id(); b.st = st;
    if (threadIdx.x == 0) (void)xb_add(&bar[XB_XCNT(b.x)], 1u);
    return b;
}
__device__ __forceinline__ void xcd_barrier_complete(unsigned* bar, unsigned x, unsigned& nloc, unsigned& nx) {
    const unsigned G = gridDim.x * gridDim.y * gridDim.z;
    unsigned sum, cnt, mine, sp = 0u;
    for (;;) {
        sum = 0u; cnt = 0u; mine = 0u;
#pragma unroll
        for (unsigned j = 0; j < 16; ++j) { const unsigned c = xb_ld(&bar[XB_XCNT(j)]); sum += c; cnt += (c > 0u) ? 1u : 0u; mine = (j == x) ? c : mine; }
        if (sum == G) break;
        __builtin_amdgcn_s_sleep(1);
        if ((++sp & 255u) == 0u) { if (xb_ld(&bar[XB_TMO])) break; if (sp > XB_SPIN_CAP) { atomicAdd(&bar[XB_TMO], 1u); break; } }
    }
    nloc = mine > 0u ? mine : 1u; nx = cnt > 0u ? cnt : 1u;
}

__device__ __forceinline__ void xcd_barrier(const XcdBarrier& b) {
    asm volatile("s_waitcnt vmcnt(0)" ::: "memory");
    __syncthreads();
    if (threadIdx.x == 0) {
        unsigned* bar = b.bar;
        __builtin_amdgcn_s_waitcnt(0);
        unsigned nloc = b.st[0], nx = b.st[1];
        if (nloc == 0u) { xcd_barrier_complete(bar, b.x, nloc, nx); b.st[0] = nloc; b.st[1] = nx; }
        const unsigned old = xb_add(&bar[XB_XSUB(b.x)], 1u);
        const unsigned gen = old / nloc;
        if (old + 1u == (gen + 1u) * nloc) {
            __builtin_amdgcn_fence(__ATOMIC_RELEASE, "agent");
            asm volatile("s_waitcnt vmcnt(0)" ::: "memory");
            const unsigned og = xb_add(&bar[XB_TOP], 1u);
            const unsigned tg = og / nx;
            if (og + 1u == (tg + 1u) * nx) xb_add(&bar[XB_TOPGEN], 1u);
            else XB_SPIN(xb_ld(&bar[XB_TOPGEN]) == tg, bar);
            __builtin_amdgcn_fence(__ATOMIC_ACQUIRE, "agent");
            xb_add(&bar[XB_XGEN(b.x)], 1u);
            asm volatile("s_waitcnt vmcnt(0)" ::: "memory");
        } else {
            XB_SPIN(xb_ld(&bar[XB_XGEN(b.x)]) == gen, bar);
            __builtin_amdgcn_fence(__ATOMIC_ACQUIRE, "agent");
            asm volatile("s_waitcnt vmcnt(0)" ::: "memory");
        }
    }
    __syncthreads();
}

struct TrDesc { const float* W; bf16_t* WT; const float* gk; int K, N, k0, n0, mode, kd; };
__device__ __forceinline__ void tr_load(const TrDesc& d, float (&vv)[32], int lane) {
    int sc = d.n0 + (lane & 31); if (d.mode == 1) sc = vsrc_in(sc);
    const float* src = d.W + (size_t)(d.k0 + (lane >> 5)) * d.N + (sc < 0 ? 0 : sc);
    const size_t step = (size_t)2 * d.N;
#pragma unroll
    for (int i = 0; i < 32; ++i) { const float v = src[i * step]; vv[i] = (sc < 0) ? 0.f : v; }
}
__device__ __forceinline__ void tr_store(const TrDesc& d, const float (&vv)[32], LAS float* scr, int lane) {
#pragma unroll
    for (int i = 0; i < 32; ++i) { const int kk = 2 * i + (lane >> 5); float v = vv[i];
        if (d.mode == 2) v *= d.gk[d.k0 + kk];
        scr[kk * 33 + (lane & 31)] = v; }
    asm volatile("s_waitcnt lgkmcnt(0)" ::: "memory");
    const int c = lane & 7;
#pragma unroll
    for (int j = 0; j < 4; ++j) { const int n = (lane >> 3) + 8 * j; const LAS float* sp = scr + (8 * c) * 33 + n;
        u32x4 o; o.x = pk2(sp[0 * 33], sp[1 * 33]); o.y = pk2(sp[2 * 33], sp[3 * 33]); o.z = pk2(sp[4 * 33], sp[5 * 33]); o.w = pk2(sp[6 * 33], sp[7 * 33]);
        *(u32x4*)(d.WT + (size_t)(d.n0 + n) * d.K + d.kd + d.k0 + 8 * c) = o; }
    asm volatile("s_waitcnt lgkmcnt(0)" ::: "memory");
}

struct Args {
    const float *x, *c; const int* pos; const float *w_ada, *b_ada, *g_pre, *w_in, *g_kv, *w_ukv, *lq1, *lk1, *lq2, *lk2, *g_subln, *w_o_mla, *w_o_diff, *w_out, *g_post;
    float* out; unsigned char* ws;
};

__global__ void __launch_bounds__(512, 2) fwd_kernel(Args A) {
    extern __shared__ __attribute__((aligned(16))) unsigned char lds_raw[];
    LAS unsigned char* lds = (LAS unsigned char*)lds_raw;
    cg::grid_group grid = cg::this_grid();
    if (A.ws == nullptr) grid.sync();
    { volatile LAS unsigned* st0 = (volatile LAS unsigned*)(lds + LDS_MISC + 64); if (threadIdx.x < 2) st0[threadIdx.x] = 0u; }
    __syncthreads();
    const XcdBarrier xbar = xcd_barrier_post((unsigned*)(A.ws + WS_CTL) + CTL_BAR, (volatile LAS unsigned*)(lds + LDS_MISC + 64));
#if PROBE_DUP == 9
#define GRID_SYNC() do { xcd_barrier(xbar); xcd_barrier(xbar); } while (0)
#else
#define GRID_SYNC() xcd_barrier(xbar)
#endif
    const int G = gridDim.x, NGW = G * 8;
#define PHASE_IDS() int tid = threadIdx.x; asm volatile("" : "+v"(tid)); const int lane = tid & 63, wave = __builtin_amdgcn_readfirstlane(tid >> 6), gw = blockIdx.x * 8 + wave; (void)lane; (void)gw
    unsigned char* ws = A.ws;
    float* ctl = (float*)(ws + WS_CTL);
    float* ssqc = ctl + CTL_SSQC; float* ssqy = ctl + CTL_SSQY; float* ada = ctl + CTL_ADA; unsigned* queue = (unsigned*)(ctl + CTL_QUEUE);
    float* ropec = (float*)(ws + WS_ROPE); float* ropes = ropec + MTOK * 32;
    bf16_t *WUKV = (bf16_t*)(ws + WS_WUKV), *WOM = (bf16_t*)(ws + WS_WOM), *WOD = (bf16_t*)(ws + WS_WOD), *WOUT = (bf16_t*)(ws + WS_WOUT), *WIN = (bf16_t*)(ws + WS_WIN);
    bf16_t *H = (bf16_t*)(ws + WS_H), *MG = (bf16_t*)(ws + WS_H);
    bf16_t *QM = (bf16_t*)(ws + WS_QM), *CKV = (bf16_t*)(ws + WS_CKV), *KM = (bf16_t*)(ws + WS_KM), *VM = (bf16_t*)(ws + WS_VM);
    bf16_t *QD = (bf16_t*)(ws + WS_QD), *KD = (bf16_t*)(ws + WS_KD), *VD = (bf16_t*)(ws + WS_VD), *GM = (bf16_t*)(ws + WS_GM), *GD = (bf16_t*)(ws + WS_GD);
    bf16_t *SM = (bf16_t*)(ws + WS_SM), *SD = (bf16_t*)(ws + WS_SD), *OM = (bf16_t*)(ws + WS_OA), *OD = (bf16_t*)(ws + WS_OA);
    bf16_t* Y = (bf16_t*)(ws + WS_Y);

    {
        PHASE_IDS();
#if PROBE_DUP == 0
#define P0SKIP(rep) ((rep) ? PROBE_DRY : 0)
        for (int rep = 0; rep < 2; ++rep) { float* ada_ = rep ? ctl + 65536 : ada;
#else
#define P0SKIP(rep) 0
        { float* ada_ = ada; const int rep = 0; (void)rep;
#endif
        LAS float* scr = (LAS float*)(lds + wave * 8448);
        constexpr int I_IN = 32 * (INWP / 32), I_UKV = 8 * 64, I_OM = 16 * 64, I_OD = 16 * 64, I_OUT = 32 * 64, I_ADA = 96 * 32;
        constexpr int NTR = I_IN + I_UKV + I_OM + I_OD + I_OUT;
        if (!(P0SKIP(rep) & 1))
        for (int r = gw; r < I_ADA; r += NGW) {
            const int cb = r % 96, kc = r / 96, j = cb * 64 + lane, k0 = kc * 64; float a0 = 0.f, a1 = 0.f;
#pragma unroll
            for (int k = 0; k < 64; ++k) { const float w = A.w_ada[(size_t)(k0 + k) * 6144 + j]; a0 += A.c[k0 + k] * w; a1 += A.c[DM + k0 + k] * w; }
            atomicAdd(ada_ + j, a0); atomicAdd(ada_ + 6144 + j, a1);
        }
#define TR_DECODE(d, it_) do { int r_ = (it_); \
            if (r_ < I_IN) { d.W = A.w_in; d.WT = WIN; d.gk = nullptr; d.kd = 0; d.K = DM; d.N = INW; d.mode = 1; d.k0 = 64 * (r_ % 32); d.n0 = 32 * (r_ / 32); } \
            else if ((r_ -= I_IN) < I_UKV) { d.W = A.w_ukv; d.WT = WUKV; d.gk = A.g_kv; d.kd = 0; d.K = 512; d.N = 2048; d.mode = 2; d.k0 = 64 * (r_ % 8); d.n0 = 32 * (r_ / 8); } \
            else if ((r_ -= I_UKV) < I_OM) { d.W = A.w_o_mla; d.WT = WOM; d.gk = nullptr; d.kd = 0; d.K = 2048; d.N = 2048; d.mode = 0; d.k0 = 64 * (r_ % 16); d.n0 = 32 * (r_ / 16); } \
            else if ((r_ -= I_OM) < I_OD) { d.W = A.w_o_diff; d.WT = WOM; d.gk = nullptr; d.kd = 1024; d.K = 2048; d.N = 2048; d.mode = 0; d.k0 = 64 * (r_ % 16); d.n0 = 32 * (r_ / 16); } \
            else { r_ -= I_OD; d.W = A.w_out; d.WT = WOUT; d.gk = nullptr; d.kd = 0; d.K = 2048; d.N = 2048; d.mode = 0; d.k0 = 64 * (r_ % 32); d.n0 = 32 * (r_ / 32); } } while (0)
        if (!(P0SKIP(rep) & 2)) {
            float va[32], vb[32]; TrDesc da, db; int it = gw;
            if (it < NTR) { TR_DECODE(da, it); tr_load(da, va, lane); }
            while (it < NTR) {
                const int i1 = it + NGW, i2 = it + 2 * NGW;
                if (i1 < NTR) { TR_DECODE(db, i1); tr_load(db, vb, lane); }
                tr_store(da, va, scr, lane);
                if (i1 >= NTR) break;
                if (i2 < NTR) { TR_DECODE(da, i2); tr_load(da, va, lane); }
                tr_store(db, vb, scr, lane);
                it = i2;
            }
        }
#undef TR_DECODE
        if (!(P0SKIP(rep) & 4)) {
            LAS float* invt = (LAS float*)(lds + 8 * 8448);
            __syncthreads();
            if (tid < 32) invt[tid] = powf(10000.0f, -(float)tid / 32.0f);
            __syncthreads();
            for (int e = blockIdx.x * 512 + tid; e < MTOK * 32; e += G * 512) {
                const int t = e >> 5, i = e & 31;
                const float ang = (float)A.pos[t] * invt[i];
                const float k = rintf(ang * 0.6366197723675814f);
                float r = fmaf(-k, 1.5703125f, ang); r = fmaf(-k, 4.837512969970703125e-4f, r); r = fmaf(-k, 7.54978995489188216e-8f, r);
                const float r2 = r * r;
                const float sn = r + r * r2 * (-1.6666667163e-1f + r2 * (8.3333337680e-3f + r2 * (-1.9841270114e-4f + r2 * 2.7557314297e-6f)));
                const float cs = 1.0f + r2 * (-0.5f + r2 * (4.1666667908e-2f + r2 * (-1.3888889225e-3f + r2 * (2.4801587642e-5f + r2 * -2.7557314297e-7f))));
                const int qd = ((int)k) & 3;
                const float s_ = (qd == 0) ? sn : (qd == 1) ? cs : (qd == 2) ? -sn : -cs;
                const float c_ = (qd == 0) ? cs : (qd == 1) ? -sn : (qd == 2) ? -cs : sn;
                ropec[e] = c_; ropes[e] = s_;
            }
        }
        }
    }
    GRID_SYNC();

    {
        PHASE_IDS();
        LAS float* mA = (LAS float*)lds;
        LAS float* mB = mA + 2 * DM;
        for (int e = tid; e < 2 * DM; e += 512) { const int b = e >> 11, n = e & 2047;
            mA[e] = A.g_pre[n] * (1.0f + ada[b * 6144 + 2048 + n] + A.b_ada[2048 + n]); mB[e] = ada[b * 6144 + n] + A.b_ada[n]; }
        __syncthreads();
        for (int m = gw; m < MTOK; m += NGW) {
            const int b = m >> 12; const f32x4* xr = (const f32x4*)(A.x + (size_t)m * DM) + lane;
            f32x4 v[8]; float s = 0.f;
#pragma unroll
            for (int j = 0; j < 8; ++j) { v[j] = xr[64 * j]; s += (v[j][0] * v[j][0] + v[j][1] * v[j][1]) + (v[j][2] * v[j][2] + v[j][3] * v[j][3]); }
            const float rstd = rsqrtf(wave_sum(s) * (1.0f / DM) + EPS);
            u32x2* o8 = (u32x2*)(H + (size_t)m * DM) + lane;
#pragma unroll
            for (int j = 0; j < 8; ++j) { const int n = b * DM + 256 * j + 4 * lane; const f32x4 a = *(const LAS f32x4*)(mA + n), sh = *(const LAS f32x4*)(mB + n);
                u32x2 w; w.x = pk2(v[j][0] * rstd * a[0] + sh[0], v[j][1] * rstd * a[1] + sh[1]); w.y = pk2(v[j][2] * rstd * a[2] + sh[2], v[j][3] * rstd * a[3] + sh[3]);
                o8[64 * j] = w; }
        }
        __syncthreads();
    }
    GRID_SYNC();

#ifndef SKIP_P2
    {
        pg8::Gemm g{H, WIN, MTOK, INWP, DM}; pg8::StaticOrder S; S.init(MTOK, INWP, G, (int)blockIdx.x);
        epi::EpiProj E{QM, CKV, QD, KD, VD, GM, GD, SM, SD, KM, ssqc, ropec, ropes};
        pg8::gemm_phase<epi::EpiProj, pg8::StaticOrder, true, true>(lds, g, S, E);
#if PROBE_DUP == 2
        __syncthreads();
        epi::EpiProj E2{QM, CKV, QD, KD, VD, GM, GD, SM, SD, KM, ctl + 65536, ropec, ropes};
        pg8::gemm_phase<epi::EpiProj, pg8::StaticOrder, true, true>(lds, g, S, E2);
#endif
    }
#endif
    GRID_SYNC();

    {
        pg8::Gemm g{CKV, WUKV, MTOK, 2048, 512}; pg8::StaticOrder S; S.init(MTOK, 2048, G, (int)blockIdx.x);
        epi::EpiUp E{KM, VM, ssqc};
        pg8::gemm_phase<epi::EpiUp, pg8::StaticOrder, true, true>(lds, g, S, E);
    }
    GRID_SYNC();

#ifndef SKIP_P4
    {
        PHASE_IDS();
        att::Ptrs P; P.QM = QM; P.KM = KM; P.VM = VM; P.QD = QD; P.KD = KD; P.VD = VD; P.GM = GM; P.GD = GD; P.OM = OM; P.OD = OD; P.pos = A.pos; P.gsub = A.g_subln;
        { const float s1 = wave_sum(A.lq1[lane] * A.lk1[lane]), s2 = wave_sum(A.lq2[lane] * A.lk2[lane]); P.lam = expf(s1) - expf(s2) + LAMBDA_INIT; }
        LAS unsigned* qslot = (LAS unsigned*)(lds + LDS_MISC);
#define ATT_RUN(M_, b_, h_, qb_) do { const int bad_ = att::attn_unit<M_, false>(lds, (b_), (h_), (qb_), P, rep ? PROBE_DRY : 0); \
            if (__syncthreads_or(bad_)) (void)att::attn_unit<M_, true>(lds, (b_), (h_), (qb_), P, rep ? PROBE_DRY : 0); } while (0)
#if PROBE_DUP == 4
        for (int rep = 0; rep < 2; ++rep)
#else
        const int rep = 0;
#endif
        if (STATIC_PLAN && G == 256) {
            const int x = blockIdx.x & 7, k = blockIdx.x >> 3;
            if (k < 16) { const int bh = 2 * x + (k >> 3), i = k & 7;
                ATT_RUN(true, bh >> 3, bh & 7, 15 - i);
                ATT_RUN(true, bh >> 3, bh & 7, i);
            } else { const int j = k - 16;
#pragma unroll 1
                for (int u = 0; u < 4; ++u) { const int bh = 2 * x + (u & 1), qb = (u < 2) ? 31 - j : j;
                    ATT_RUN(false, bh >> 3, bh & 7, qb); }
            }
        } else
        for (;;) {
            __syncthreads();
            if (tid == 0) *qslot = atomicAdd(queue + rep, 1u);
            __syncthreads();
            int rem = (int)*qslot;
            if (rem >= 768) break;
            int type = -1, qb = 0;
            for (int cv = 160; cv >= 3; --cv) {
                if (cv % 10 == 0) { if (rem < 16) { type = 0; qb = cv / 10 - 1; break; } rem -= 16; }
                if (cv % 3 == 0 && cv <= 96) { if (rem < 16) { type = 1; qb = cv / 3 - 1; break; } rem -= 16; }
            }
            const int b = rem >> 3, h = rem & 7;
            if (type == 0) ATT_RUN(true, b, h, qb);
            else ATT_RUN(false, b, h, qb);
        }
        __syncthreads();
    }
#endif
    GRID_SYNC();

    {
        pg8::StaticOrder S; S.init(MTOK, DM, G, (int)blockIdx.x);
        pg8::Gemm g{OM, WOM, MTOK, DM, 2048}; epi::EpiMerge E{SD, MG}; epi::HookMerge Hk{SM, SD};
        pg8::gemm_phase<epi::EpiMerge, pg8::StaticOrder, true, true, epi::HookMerge>(lds, g, S, E, Hk);
    }
    GRID_SYNC();

    {
        pg8::Gemm g{MG, WOUT, MTOK, DM, DM}; pg8::StaticOrder S; S.init(MTOK, DM, G, (int)blockIdx.x);
        epi::EpiOut E{Y, ssqy};
        pg8::gemm_phase<epi::EpiOut, pg8::StaticOrder, true, true>(lds, g, S, E);
    }
    GRID_SYNC();

    {
        PHASE_IDS();
        LAS float* gg = (LAS float*)lds;
        for (int e = tid; e < 2 * DM; e += 512) { const int b = e >> 11, n = e & 2047; gg[e] = (ada[b * 6144 + 4096 + n] + A.b_ada[4096 + n]) * A.g_post[n]; }
        __syncthreads();
        for (int m = gw; m < MTOK; m += NGW) {
            const int b = m >> 12; const float rstd = rsqrtf(ssqy[m] * (1.0f / DM) + EPS);
            const f32x4* xr = (const f32x4*)(A.x + (size_t)m * DM) + lane; const u32x2* yr = (const u32x2*)(Y + (size_t)m * DM) + lane; f32x4* orow = (f32x4*)(A.out + (size_t)m * DM) + lane;
#pragma unroll
            for (int j = 0; j < 8; ++j) { const f32x4 g4 = *(const LAS f32x4*)(gg + b * DM + 256 * j + 4 * lane); const u32x2 yy = yr[64 * j]; const f32x4 y4 = {bflo(yy.x), bfhi(yy.x), bflo(yy.y), bfhi(yy.y)};
                orow[64 * j] = xr[64 * j] + y4 * g4 * rstd; }
        }
    }
}

extern "C" void kernel_launch(void* const* d_in, const int* in_sizes, int n_in, void* d_out, int out_size, void* d_ws, size_t ws_size, hipStream_t stream) {
    static int grid_blocks = 0;
    if (grid_blocks == 0) {
        if (n_in != 18 || in_sizes[0] != MTOK * DM || out_size != MTOK * DM || ws_size < WS_END) { fprintf(stderr, "kernel_launch: unexpected shapes (n_in %d, in0 %d, out %d, ws %zu)\n", n_in, n_in > 0 ? in_sizes[0] : -1, out_size, ws_size); grid_blocks = -1; return; }
        int dev = 0, cus = 0, per_cu = 0;
        (void)hipGetDevice(&dev); (void)hipDeviceGetAttribute(&cus, hipDeviceAttributeMultiprocessorCount, dev);
        if (hipFuncSetAttribute((const void*)fwd_kernel, hipFuncAttributeMaxDynamicSharedMemorySize, LDS_BYTES) != hipSuccess) { fprintf(stderr, "kernel_launch: hipFuncSetAttribute failed\n"); grid_blocks = -1; return; }
        if (hipOccupancyMaxActiveBlocksPerMultiprocessor(&per_cu, (const void*)fwd_kernel, 512, LDS_BYTES) != hipSuccess || per_cu < 1) { fprintf(stderr, "kernel_launch: occupancy query says %d\n", per_cu); per_cu = 1; }
        (void)hipGetLastError();
        grid_blocks = cus;
    }
    if (grid_blocks < 0) return;
    (void)hipMemsetAsync((char*)d_ws + WS_CTL, 0, CTL_BYTES, stream);
    Args a{};
    a.x = (const float*)d_in[0]; a.c = (const float*)d_in[1]; a.pos = (const int*)d_in[2]; a.w_ada = (const float*)d_in[3]; a.b_ada = (const float*)d_in[4]; a.g_pre = (const float*)d_in[5];
    a.w_in = (const float*)d_in[6]; a.g_kv = (const float*)d_in[7]; a.w_ukv = (const float*)d_in[8]; a.lq1 = (const float*)d_in[9]; a.lk1 = (const float*)d_in[10]; a.lq2 = (const float*)d_in[11]; a.lk2 = (const float*)d_in[12];
    a.g_subln = (const float*)d_in[13]; a.w_o_mla = (const float*)d_in[14]; a.w_o_diff = (const float*)d_in[15]; a.w_out = (const float*)d_in[16]; a.g_post = (const float*)d_in[17];
    a.out = (float*)d_out; a.ws = (unsigned char*)d_ws;
    void* args[] = {&a};
    hipError_t e = hipLaunchCooperativeKernel((const void*)fwd_kernel, dim3(grid_blocks), dim3(512), args, LDS_BYTES, stream);
    if (e != hipSuccess) fprintf(stderr, "cooperative launch failed: %s (grid %d)\n", hipGetErrorString(e), grid_blocks);
}
```
